# Optimizing an MI355X kernel written in HIP

```python
import math
import jax, jax.numpy as jnp
from jax import lax
import numpy as np

D_MODEL = 1024
BATCH = 4
SEQ = 8192
DEPTH = 4

MIX_WIDTH = D_MODEL
HEAD_DIM = 64
CONV_WIDTH = D_MODEL // 4
NSA_HEADS = 8
NSA_KV_GROUPS = 2
NSA_WIDTH = NSA_HEADS * HEAD_DIM
KV_WIDTH = NSA_KV_GROUPS * HEAD_DIM
MEM_HEADS = 4
MEM_WIDTH = MEM_HEADS * HEAD_DIM
N_MEM = 256
CONV_K = 3
CMP_BLOCK = 32
CMP_STRIDE = 16
CMP_HIDDEN = 256
SEL_BLOCK = 64
SEL_TOPK = 16
WINDOW = 512
Q_BLOCK = 128
N_BRANCH = 3
RMS_EPS = 1e-6
FORCE_SCORE = 1e4
IN_SPLITS = (CONV_WIDTH, CONV_WIDTH, CONV_WIDTH, CONV_WIDTH,
             NSA_WIDTH, KV_WIDTH, KV_WIDTH, KV_WIDTH, KV_WIDTH, KV_WIDTH, KV_WIDTH,
             N_BRANCH * NSA_HEADS, NSA_WIDTH,
             MEM_WIDTH, MEM_WIDTH)
IN_WIDTH = sum(IN_SPLITS)

kernel_name = "hymba_conv_nsa_memory_trunk"


def rmsnorm(x, g):
    xf = x.astype(jnp.float32)
    y = xf * lax.rsqrt(jnp.mean(xf * xf, axis=-1, keepdims=True) + RMS_EPS)
    return (y * g.astype(jnp.float32)).astype(x.dtype)


def alibi_slopes(n):
    return jnp.exp2(-8.0 * jnp.arange(1, n + 1, dtype=jnp.float32) / n)


def masked_softmax(s, mask):
    s = jnp.where(mask, s.astype(jnp.float32), -jnp.inf)
    m = jnp.max(s, axis=-1, keepdims=True)
    m = jnp.where(jnp.isfinite(m), m, 0.0)
    p = jnp.exp(s - m)
    return p / jnp.maximum(jnp.sum(p, axis=-1, keepdims=True), 1e-30)


def short_conv(b, c, h, w, bias):
    T = h.shape[1]
    up = jnp.pad(c * h, ((0, 0), (CONV_K - 1, 0), (0, 0)))
    y = bias + up[:, 0:T] * w[0]
    for k in range(1, CONV_K):
        y = y + up[:, k:k + T] * w[k]
    return b * y


def compress_kv(k, pos, w1, w2):
    B, G, T, HD = k.shape
    ch = k.reshape(B, G, T // CMP_STRIDE, CMP_STRIDE, HD)
    blocks = jnp.concatenate([ch[:, :, :-1], ch[:, :, 1:]], axis=3) + pos
    flat = blocks.reshape(B, G, blocks.shape[2], CMP_BLOCK * HD)
    return jax.nn.gelu(flat @ w1) @ w2


def nsa_attention(q, k_cmp, v_cmp, k_sel, v_sel, k_win, v_win, gate_logits,
                  pos_k, w1_k, w2_k, pos_v, w1_v, w2_v):
    B, T, _ = q.shape
    G, R, HD = NSA_KV_GROUPS, NSA_HEADS // NSA_KV_GROUPS, HEAD_DIM
    n_cmp = T // CMP_STRIDE - 1
    n_sel = T // SEL_BLOCK
    top_k = min(SEL_TOPK, n_sel)
    n_qb = T // Q_BLOCK

    def to_heads(t, n):
        return t.reshape(B, T, n, HD).transpose(0, 2, 1, 3)

    qh = (to_heads(q, NSA_HEADS) * HD ** -0.5).reshape(B, G, R, T, HD)
    kc = compress_kv(to_heads(k_cmp, G), pos_k, w1_k, w2_k)
    vc = compress_kv(to_heads(v_cmp, G), pos_v, w1_v, w2_v)
    ks_blk = to_heads(k_sel, G).reshape(B, G, n_sel, SEL_BLOCK, HD)
    vs_blk = to_heads(v_sel, G).reshape(B, G, n_sel, SEL_BLOCK, HD)
    wpad = ((0, 0), (0, 0), (WINDOW, 0), (0, 0))
    kw = jnp.pad(to_heads(k_win, G), wpad)
    vw = jnp.pad(to_heads(v_win, G), wpad)
    gates = jax.nn.sigmoid(gate_logits.astype(jnp.float32))
    gates = gates.reshape(B, T, N_BRANCH, G, R).transpose(2, 0, 3, 4, 1)[..., None]
    slopes = alibi_slopes(NSA_HEADS).reshape(1, G, R, 1, 1)
    cmp_end = jnp.arange(n_cmp) * CMP_STRIDE + (CMP_BLOCK - 1)
    blk = jnp.arange(n_sel)
    b_ix = jnp.arange(B)[:, None, None, None]
    g_ix = jnp.arange(G)[None, :, None, None]

    def step(qb):
        q0 = qb * Q_BLOCK
        qi = lax.dynamic_slice_in_dim(qh, q0, Q_BLOCK, axis=3)
        gi = lax.dynamic_slice_in_dim(gates, q0, Q_BLOCK, axis=4)
        t = q0 + jnp.arange(Q_BLOCK)
        d_c = (t[:, None] - cmp_end[None, :]).astype(jnp.float32)
        s_c = jnp.einsum('bgrqd,bgnd->bgrqn', qi, kc) - slopes * d_c
        p_c = masked_softmax(s_c, d_c >= 0)
        o_cmp = jnp.einsum('bgrqn,bgnd->bgrqd', p_c, vc)
        imp = jnp.sum(p_c, axis=2)
        chunk = (jnp.pad(imp, ((0, 0), (0, 0), (0, 0), (0, 1)))
                 + jnp.pad(imp, ((0, 0), (0, 0), (0, 0), (1, 0))))
        imp_sel = chunk.reshape(B, G, Q_BLOCK, n_sel, SEL_BLOCK // CMP_STRIDE).sum(-1)
        cur = t // SEL_BLOCK
        forced = ((blk[None, :] == 0) | (blk[None, :] == cur[:, None])
                  | (blk[None, :] == cur[:, None] - 1))
        future = blk[None, :] > cur[:, None]
        imp_sel = jnp.where(forced, FORCE_SCORE, jnp.where(future, -1.0, imp_sel))
        _, idx = lax.top_k(imp_sel, top_k)
        k_g = ks_blk[b_ix, g_ix, idx]
        v_g = vs_blk[b_ix, g_ix, idx]
        spos = idx[..., None] * SEL_BLOCK + jnp.arange(SEL_BLOCK)
        d_s = (t[:, None, None] - spos).astype(jnp.float32)[:, :, None]
        s_s = jnp.einsum('bgrqd,bgqnsd->bgrqns', qi, k_g) - slopes[..., None] * d_s
        m_s = jnp.broadcast_to(d_s >= 0, s_s.shape)
        shp = s_s.shape
        p_s = masked_softmax(s_s.reshape(shp[:4] + (-1,)), m_s.reshape(shp[:4] + (-1,))).reshape(shp)
        o_sel = jnp.einsum('bgrqns,bgqnsd->bgrqd', p_s, v_g)
        kwi = lax.dynamic_slice_in_dim(kw, q0, Q_BLOCK + WINDOW, axis=2)
        vwi = lax.dynamic_slice_in_dim(vw, q0, Q_BLOCK + WINDOW, axis=2)
        wpos = q0 - WINDOW + jnp.arange(Q_BLOCK + WINDOW)
        d_w = t[:, None] - wpos[None, :]
        m_w = (d_w >= 0) & (d_w < WINDOW) & (wpos[None, :] >= 0)
        s_w = jnp.einsum('bgrqd,bgsd->bgrqs', qi, kwi) - slopes * d_w.astype(jnp.float32)
        o_win = jnp.einsum('bgrqs,bgsd->bgrqd', masked_softmax(s_w, m_w), vwi)
        return gi[0] * o_cmp + gi[1] * o_sel + gi[2] * o_win

    out = lax.map(step, jnp.arange(n_qb))
    return out.transpose(1, 0, 4, 2, 3, 5).reshape(B, T, NSA_WIDTH).astype(q.dtype)


def memory_attention(q, mem_n, w_mem_kv):
    B, T, _ = q.shape
    kv = mem_n @ w_mem_kv
    k, v = jnp.split(kv, 2, axis=-1)
    qh = q.reshape(B, T, MEM_HEADS, HEAD_DIM) * HEAD_DIM ** -0.5
    kh = k.reshape(B, -1, MEM_HEADS, HEAD_DIM)
    vh = v.reshape(B, -1, MEM_HEADS, HEAD_DIM)
    p = jax.nn.softmax(jnp.einsum('bthd,bmhd->bhtm', qh, kh).astype(jnp.float32), axis=-1)
    o = jnp.einsum('bhtm,bmhd->bthd', p, vh)
    return o.reshape(B, T, MEM_WIDTH).astype(q.dtype)


def setup_inputs(seed: int = 0) -> dict:
    key = jax.random.key(seed)
    ks = jax.random.split(key, 20)
    L, D = DEPTH, D_MODEL
    f32 = jnp.float32

    def nrm(k, shape, fan_in):
        return jax.random.normal(k, shape, f32) * fan_in ** -0.5

    def gain(k):
        return 1.0 + 0.02 * jax.random.normal(k, (L, D), f32)

    return {
        "x": jax.random.normal(ks[0], (BATCH, SEQ, D), f32),
        "mem": jax.random.normal(ks[1], (BATCH, N_MEM, D), f32),
        "pre_norm_g": gain(ks[2]),
        "post_norm_g": gain(ks[3]),
        "mem_norm_g": gain(ks[4]),
        "w_in": nrm(ks[5], (L, D, IN_WIDTH), D),
        "b_gate": 0.01 * jax.random.normal(ks[6], (L, N_BRANCH * NSA_HEADS), f32),
        "conv_w": nrm(ks[7], (L, CONV_K, CONV_WIDTH), CONV_K),
        "conv_b": 0.01 * jax.random.normal(ks[8], (L, CONV_WIDTH), f32),
        "cmp_pos_k": 0.02 * jax.random.normal(ks[9], (L, CMP_BLOCK, HEAD_DIM), f32),
        "cmp_w1_k": nrm(ks[10], (L, CMP_BLOCK * HEAD_DIM, CMP_HIDDEN), CMP_BLOCK * HEAD_DIM),
        "cmp_w2_k": nrm(ks[11], (L, CMP_HIDDEN, HEAD_DIM), CMP_HIDDEN),
        "cmp_pos_v": 0.02 * jax.random.normal(ks[12], (L, CMP_BLOCK, HEAD_DIM), f32),
        "cmp_w1_v": nrm(ks[13], (L, CMP_BLOCK * HEAD_DIM, CMP_HIDDEN), CMP_BLOCK * HEAD_DIM),
        "cmp_w2_v": nrm(ks[14], (L, CMP_HIDDEN, HEAD_DIM), CMP_HIDDEN),
        "w_mem_kv": nrm(ks[15], (L, D, 2 * MEM_WIDTH), D),
        "w_out": nrm(ks[16], (L, MIX_WIDTH, D), MIX_WIDTH),
    }


def reference(x, mem, pre_norm_g, post_norm_g, mem_norm_g, w_in, b_gate, conv_w, conv_b,
              cmp_pos_k, cmp_w1_k, cmp_w2_k, cmp_pos_v, cmp_w1_v, cmp_w2_v, w_mem_kv, w_out):
    offs = np.cumsum(IN_SPLITS)[:-1].tolist()
    for l in range(DEPTH):
        h = rmsnorm(x, pre_norm_g[l])
        proj = h @ w_in[l]
        (c_b, c_c, c_h, c_gate, n_q, n_kc, n_vc, n_ks, n_vs, n_kw, n_vw,
         n_glog, n_gate, m_q, m_gate) = jnp.split(proj, offs, axis=-1)
        y_conv = short_conv(c_b, c_c, c_h, conv_w[l], conv_b[l]) * jax.nn.silu(c_gate)
        y_nsa = nsa_attention(n_q, n_kc, n_vc, n_ks, n_vs, n_kw, n_vw, n_glog + b_gate[l],
                              cmp_pos_k[l], cmp_w1_k[l], cmp_w2_k[l],
                              cmp_pos_v[l], cmp_w1_v[l], cmp_w2_v[l]) * jax.nn.silu(n_gate)
        y_mem = memory_attention(m_q, rmsnorm(mem, mem_norm_g[l]), w_mem_kv[l]) * jax.nn.silu(m_gate)
        y = jnp.concatenate([y_conv, y_nsa, y_mem], axis=-1) @ w_out[l]
        x = x + rmsnorm(y, post_norm_g[l])
    return x
```

```cpp
#include <hip/hip_cooperative_groups.h>

#include <hip/hip_runtime.h>
#include <cstdio>
#include <cstdint>
#include <cmath>

typedef unsigned short bf16_t;

constexpr int L_ = 4, B_ = 4, T_ = 8192, D_ = 1024, M_ = B_ * T_;
constexpr int INW = 3352;
constexpr int NP = 3584;
constexpr int NMEM = 256;
constexpr float EPS = 1e-6f;
constexpr float LOG2E = 1.4426950408889634f;
constexpr float C2 = 0.125f * LOG2E;

constexpr int PC_CB = 0, PC_CC = 256, PC_CH = 512, PC_CG = 768, PC_Q = 1024, PC_KC = 1536, PC_VC = 1664,
              PC_KS = 1792, PC_VS = 1920, PC_KW = 2048, PC_VW = 2176, PC_NG = 2304, PC_MQ = 2816, PC_MG = 3072, PC_GL = 3328;

constexpr size_t al256(size_t x) { return (x + 255) & ~(size_t)255; }
constexpr size_t WS_WIN = 0;
constexpr size_t WS_WOUT = WS_WIN + al256((size_t)L_ * NP * D_ * 2);
constexpr size_t WS_W1T = WS_WOUT + al256((size_t)L_ * D_ * D_ * 2);
constexpr size_t WS_W2T = WS_W1T + al256((size_t)L_ * 2 * 256 * 2048 * 2);
constexpr size_t WS_CB1 = WS_W2T + al256((size_t)L_ * 2 * 64 * 256 * 2);
constexpr size_t WS_WMKV = WS_CB1 + al256((size_t)L_ * 2 * 256 * 4);
constexpr size_t WS_MEMN = WS_WMKV + al256((size_t)L_ * 512 * D_ * 2);
constexpr size_t WS_MKV = WS_MEMN + al256((size_t)L_ * B_ * NMEM * D_ * 2);
constexpr size_t WS_XN = WS_MKV + al256((size_t)L_ * B_ * NMEM * 512 * 2);
constexpr size_t WS_CMPB = WS_XN + al256((size_t)M_ * D_ * 2);
constexpr size_t WS_KVC = WS_CMPB + al256((size_t)2 * B_ * 2 * T_ * 64 * 2 + 65536);
constexpr size_t WS_Y = WS_KVC + al256((size_t)2 * B_ * 2 * 512 * 64 * 2);
constexpr size_t WS_PROJ = WS_Y + al256((size_t)M_ * D_ * 2);
constexpr size_t WS_END = WS_PROJ + al256((size_t)M_ * NP * 2);

__device__ __forceinline__ float bf2f(bf16_t v) { return __uint_as_float((unsigned)v << 16); }
__device__ __forceinline__ bf16_t f2bf(float f) { unsigned u = __float_as_uint(f); return (bf16_t)((u + 0x7fffu + ((u >> 16) & 1u)) >> 16); }
__device__ __forceinline__ float wave_sum(float v) {
#pragma unroll
    for (int o = 1; o < 64; o <<= 1) v += __shfl_xor(v, o);
    return v;
}
__device__ __forceinline__ float wave_max(float v) {
#pragma unroll
    for (int o = 1; o < 64; o <<= 1) v = fmaxf(v, __shfl_xor(v, o));
    return v;
}
__device__ __forceinline__ float silu_f(float x) { return x / (1.f + __expf(-x)); }
__device__ __forceinline__ float sigmoid_f(float x) { return 1.f / (1.f + __expf(-x)); }
__device__ __forceinline__ float gelu_tanh(float x) {
    const float u = 0.7978845608028654f * (x + 0.044715f * x * x * x);
    return 0.5f * x * (1.f + tanhf(u));
}
__host__ __device__ __forceinline__ int orig_col(int pc) {
    if (pc < 2304) return pc;
    if (pc < 3328) return pc + 24;
    if (pc < 3352) return pc - 3328 + 2304;
    return -1;
}

__global__ __launch_bounds__(256) void k_transpose(const float* __restrict__ src, int ldsrc, int K, int N, bf16_t* __restrict__ dst, int mode) {
    __shared__ float tile[64][65];
    const int n0 = blockIdx.x * 64, k0 = blockIdx.y * 64, tid = threadIdx.x;
    for (int i = 0; i < 16; ++i) {
        const int kk = i * 4 + (tid >> 6), nn = tid & 63, n = n0 + nn;
        float v = 0.f;
        if (mode == 1) { const int oc = orig_col(n); if (oc >= 0) { v = src[(size_t)(k0 + kk) * ldsrc + oc]; if ((n >= PC_Q && n < PC_Q + 512) || (n >= PC_MQ && n < PC_MQ + 256)) v *= C2; } }
        else v = src[(size_t)(k0 + kk) * ldsrc + n];
        tile[kk][nn] = v;
    }
    __syncthreads();
    for (int i = 0; i < 16; ++i) {
        const int nn = i * 4 + (tid >> 6), kk = tid & 63;
        dst[(size_t)(n0 + nn) * K + k0 + kk] = f2bf(tile[kk][nn]);
    }
}
__global__ __launch_bounds__(256) void k_cmp_bias(const float* __restrict__ pos, const float* __restrict__ w1, float* __restrict__ out) {
    const int j = threadIdx.x; float acc = 0.f;
    for (int k = 0; k < 2048; ++k) acc += pos[k] * w1[(size_t)k * 256 + j];
    out[j] = acc;
}
__global__ __launch_bounds__(256) void k_rmsnorm_rows(const float* __restrict__ x, const float* __restrict__ g, bf16_t* __restrict__ out, int nrows) {
    const int row = blockIdx.x * 4 + (threadIdx.x >> 6), lane = threadIdx.x & 63;
    if (row >= nrows) return;
    const float4* xr = (const float4*)(x + (size_t)row * D_);
    float4 v[4]; float s = 0.f;
#pragma unroll
    for (int j = 0; j < 4; ++j) { v[j] = xr[lane + 64 * j]; s += v[j].x * v[j].x + v[j].y * v[j].y + v[j].z * v[j].z + v[j].w * v[j].w; }
    const float r = rsqrtf(wave_sum(s) * (1.f / D_) + EPS);
#pragma unroll
    for (int j = 0; j < 4; ++j) {
        const float4 gg = ((const float4*)g)[lane + 64 * j];
        bf16_t* o = out + (size_t)row * D_ + (lane + 64 * j) * 4;
        o[0] = f2bf(v[j].x * r * gg.x); o[1] = f2bf(v[j].y * r * gg.y); o[2] = f2bf(v[j].z * r * gg.z); o[3] = f2bf(v[j].w * r * gg.w);
    }
}

struct EpiProj { bf16_t* proj; bf16_t* cmpb; };
struct EpiZ { float* z; };
struct EpiMkv { bf16_t* o; };
__device__ __forceinline__ void epi_store(const EpiProj& e, int row, int col, float v) {
    e.proj[(size_t)row * NP + col] = f2bf(v);
    if (col >= PC_KC && col < PC_KC + 256) {
        const int c = col - PC_KC, kv = c >> 7, g = (c >> 6) & 1, d = c & 63, b = row / T_, t = row % T_;
        e.cmpb[((size_t)((kv * B_ + b) * 2 + g) * T_ + t) * 64 + d] = f2bf(v);
    }
}
__device__ __forceinline__ void epi_store(const EpiZ& e, int row, int col, float v) { e.z[(size_t)row * D_ + col] = v; }
__device__ __forceinline__ void epi_store(const EpiMkv& e, int row, int col, float v) { e.o[(size_t)row * 512 + col] = f2bf(v); }

template <class Epi>
__global__ __launch_bounds__(256) void k_gemm_naive(const bf16_t* __restrict__ A, const bf16_t* __restrict__ Bt, int K, Epi e) {
    __shared__ float As[32][68];
    __shared__ float Bs[32][68];
    const int tid = threadIdx.x, tx = tid & 15, ty = tid >> 4;
    const int m0 = blockIdx.y * 64, n0 = blockIdx.x * 64;
    float acc[4][4] = {};
    const int lr = tid >> 2, lk = (tid & 3) * 8;
    for (int k0 = 0; k0 < K; k0 += 32) {
        const uint4 av = *(const uint4*)(A + (size_t)(m0 + lr) * K + k0 + lk);
        const uint4 bv = *(const uint4*)(Bt + (size_t)(n0 + lr) * K + k0 + lk);
        const unsigned aw[4] = {av.x, av.y, av.z, av.w}, bw[4] = {bv.x, bv.y, bv.z, bv.w};
#pragma unroll
        for (int i = 0; i < 4; ++i) {
            As[lk + 2 * i][lr] = __uint_as_float(aw[i] << 16); As[lk + 2 * i + 1][lr] = __uint_as_float(aw[i] & 0xffff0000u);
            Bs[lk + 2 * i][lr] = __uint_as_float(bw[i] << 16); Bs[lk + 2 * i + 1][lr] = __uint_as_float(bw[i] & 0xffff0000u);
        }
        __syncthreads();
#pragma unroll
        for (int k = 0; k < 32; ++k) {
            const float4 a = *(const float4*)&As[k][ty * 4];
            const float4 b = *(const float4*)&Bs[k][tx * 4];
            const float aa[4] = {a.x, a.y, a.z, a.w}, bb[4] = {b.x, b.y, b.z, b.w};
#pragma unroll
            for (int i = 0; i < 4; ++i)
#pragma unroll
                for (int j = 0; j < 4; ++j) acc[i][j] += aa[i] * bb[j];
        }
        __syncthreads();
    }
#pragma unroll
    for (int i = 0; i < 4; ++i)
#pragma unroll
        for (int j = 0; j < 4; ++j) epi_store(e, m0 + ty * 4 + i, n0 + tx * 4 + j, acc[i][j]);
}

__global__ __launch_bounds__(256) void k_compress_naive(const bf16_t* __restrict__ cmpb, const float* __restrict__ pos_k, const float* __restrict__ w1_k, const float* __restrict__ w2_k,
                                                        const float* __restrict__ pos_v, const float* __restrict__ w1_v, const float* __restrict__ w2_v, bf16_t* __restrict__ kvc) {
    __shared__ float flat[2048];
    __shared__ float hid[256];
    const int i = blockIdx.x & 511, bg = (blockIdx.x >> 9) & 7, kv = blockIdx.x >> 12, tid = threadIdx.x;
    bf16_t* out = kvc + ((size_t)(kv * 8 + bg) * 512 + i) * 64;
    if (i == 511) { if (tid < 64) out[tid] = 0; return; }
    const float* pos = kv ? pos_v : pos_k; const float* w1 = kv ? w1_v : w1_k; const float* w2 = kv ? w2_v : w2_k;
    const bf16_t* src = cmpb + ((size_t)(kv * 8 + bg) * T_ + 16 * i) * 64;
    for (int k = tid; k < 2048; k += 256) flat[k] = bf2f(src[k]) + pos[k];
    __syncthreads();
    float acc = 0.f;
    for (int k = 0; k < 2048; ++k) acc += flat[k] * w1[(size_t)k * 256 + tid];
    hid[tid] = gelu_tanh(acc);
    __syncthreads();
    if (tid < 64) { float o = 0.f; for (int j = 0; j < 256; ++j) o += hid[j] * w2[j * 64 + tid]; out[tid] = f2bf(o); }
}

__device__ __forceinline__ float slope2_of(int hd) { return exp2f(-(float)(hd + 1)) * LOG2E; }
__device__ __forceinline__ void dot4(const float (*q)[64], const bf16_t* row, float& d0, float& d1, float& d2, float& d3) {
    d0 = d1 = d2 = d3 = 0.f;
#pragma unroll 1
    for (int c = 0; c < 8; ++c) {
        const uint4 v = ((const uint4*)row)[c];
        const unsigned w[4] = {v.x, v.y, v.z, v.w};
#pragma unroll
        for (int i = 0; i < 4; ++i) {
            const float lo = __uint_as_float(w[i] << 16), hi = __uint_as_float(w[i] & 0xffff0000u);
            const int d = c * 8 + 2 * i;
            d0 += q[0][d] * lo + q[0][d + 1] * hi; d1 += q[1][d] * lo + q[1][d + 1] * hi;
            d2 += q[2][d] * lo + q[2][d + 1] * hi; d3 += q[3][d] * lo + q[3][d + 1] * hi;
        }
    }
}
__device__ __forceinline__ void softmax4(float (*sc)[1024], int n, int lane) {
    for (int h = 0; h < 4; ++h) {
        float mx = -INFINITY;
        for (int j = lane; j < n; j += 64) mx = fmaxf(mx, sc[h][j]);
        mx = wave_max(mx);
        if (!(mx > -INFINITY)) mx = 0.f;
        float sum = 0.f;
        for (int j = lane; j < n; j += 64) { const float p = exp2f(sc[h][j] - mx); sc[h][j] = p; sum += p; }
        sum = wave_sum(sum);
        const float inv = 1.f / fmaxf(sum, 1e-30f);
        for (int j = lane; j < n; j += 64) sc[h][j] *= inv;
    }
}
__global__ __launch_bounds__(64) void k_nsa_naive(const bf16_t* __restrict__ proj, const bf16_t* __restrict__ kvc, const float* __restrict__ b_gate, bf16_t* __restrict__ Y) {
    __shared__ float s_q[4][64];
    __shared__ float s_sc[4][1024];
    __shared__ float s_imp[512];
    __shared__ float s_isel[128];
    __shared__ float s_o[3][4][64];
    __shared__ int s_blk[16];
    const int lane = threadIdx.x;
    const int g = blockIdx.x & 1, m = blockIdx.x >> 1, b = m / T_, t = m % T_;
    const bf16_t* prow = proj + (size_t)m * NP;
    for (int h = 0; h < 4; ++h) s_q[h][lane] = bf2f(prow[PC_Q + (g * 4 + h) * 64 + lane]);
    __syncthreads();
    const float sl0 = slope2_of(g * 4 + 0), sl1 = slope2_of(g * 4 + 1), sl2 = slope2_of(g * 4 + 2), sl3 = slope2_of(g * 4 + 3);
    const int nv = t >= 31 ? min((t - 31) / 16 + 1, 511) : 0;
    const bf16_t* kc = kvc + (size_t)((0 * B_ + b) * 2 + g) * 512 * 64;
    const bf16_t* vc = kvc + (size_t)((1 * B_ + b) * 2 + g) * 512 * 64;
    for (int i = lane; i < nv; i += 64) {
        float d0, d1, d2, d3; dot4(s_q, kc + i * 64, d0, d1, d2, d3);
        const float dist = (float)(t - (16 * i + 31));
        s_sc[0][i] = d0 - sl0 * dist; s_sc[1][i] = d1 - sl1 * dist; s_sc[2][i] = d2 - sl2 * dist; s_sc[3][i] = d3 - sl3 * dist;
    }
    __syncthreads();
    softmax4(s_sc, nv, lane);
    __syncthreads();
    {
        float o0 = 0.f, o1 = 0.f, o2 = 0.f, o3 = 0.f;
        for (int i = 0; i < nv; ++i) { const float v = bf2f(vc[i * 64 + lane]); o0 += s_sc[0][i] * v; o1 += s_sc[1][i] * v; o2 += s_sc[2][i] * v; o3 += s_sc[3][i] * v; }
        s_o[0][0][lane] = o0; s_o[0][1][lane] = o1; s_o[0][2][lane] = o2; s_o[0][3][lane] = o3;
    }
    for (int i = lane; i < 512; i += 64) s_imp[i] = i < nv ? (s_sc[0][i] + s_sc[1][i] + s_sc[2][i] + s_sc[3][i]) : 0.f;
    __syncthreads();
    const int cur = t >> 6;
    for (int blk = lane; blk < 128; blk += 64) {
        float v = (blk > 0 ? s_imp[4 * blk - 1] : 0.f) + 2.f * (s_imp[4 * blk] + s_imp[4 * blk + 1] + s_imp[4 * blk + 2]) + s_imp[4 * blk + 3];
        if (blk == 0 || blk == cur || blk == cur - 1) v = 1e4f; else if (blk > cur) v = -1.f;
        s_isel[blk] = v;
    }
    __syncthreads();
    bool sel0, sel1;
    {
        const float v0 = s_isel[lane], v1 = s_isel[lane + 64]; int r0 = 0, r1 = 0;
        for (int o = 0; o < 128; ++o) { const float vo = s_isel[o]; r0 += (vo > v0 || (vo == v0 && o < lane)) ? 1 : 0; r1 += (vo > v1 || (vo == v1 && o < lane + 64)) ? 1 : 0; }
        sel0 = r0 < 16 && lane <= cur; sel1 = r1 < 16 && lane + 64 <= cur;
    }
    const unsigned long long m0 = __ballot(sel0), m1 = __ballot(sel1);
    int nsel = 0;
    {
        unsigned long long mm = m0; int base = 0;
        for (int pass = 0; pass < 2; ++pass) {
            while (mm) { const int bit = __ffsll((long long)mm) - 1; mm &= mm - 1; if (lane == 0) s_blk[nsel] = base + bit; ++nsel; }
            mm = m1; base = 64;
        }
    }
    __syncthreads();
    for (int k = 0; k < nsel; ++k) {
        const int pos = s_blk[k] * 64 + lane;
        float d0, d1, d2, d3; dot4(s_q, proj + (size_t)(b * T_ + pos) * NP + PC_KS + g * 64, d0, d1, d2, d3);
        const float dist = (float)(t - pos); const bool ok = pos <= t;
        s_sc[0][k * 64 + lane] = ok ? d0 - sl0 * dist : -INFINITY; s_sc[1][k * 64 + lane] = ok ? d1 - sl1 * dist : -INFINITY;
        s_sc[2][k * 64 + lane] = ok ? d2 - sl2 * dist : -INFINITY; s_sc[3][k * 64 + lane] = ok ? d3 - sl3 * dist : -INFINITY;
    }
    __syncthreads();
    softmax4(s_sc, nsel * 64, lane);
    __syncthreads();
    {
        float o0 = 0.f, o1 = 0.f, o2 = 0.f, o3 = 0.f;
        for (int k = 0; k < nsel; ++k) {
            const bf16_t* vr = proj + (size_t)(b * T_ + s_blk[k] * 64) * NP + PC_VS + g * 64 + lane;
            for (int j = 0; j < 64; ++j) { const float v = bf2f(vr[(size_t)j * NP]); const int jj = k * 64 + j; o0 += s_sc[0][jj] * v; o1 += s_sc[1][jj] * v; o2 += s_sc[2][jj] * v; o3 += s_sc[3][jj] * v; }
        }
        s_o[1][0][lane] = o0; s_o[1][1][lane] = o1; s_o[1][2][lane] = o2; s_o[1][3][lane] = o3;
    }
    __syncthreads();
    for (int jj = 0; jj < 8; ++jj) {
        const int j = jj * 64 + lane, pos = t - 511 + j;
        if (pos >= 0) {
            float d0, d1, d2, d3; dot4(s_q, proj + (size_t)(b * T_ + pos) * NP + PC_KW + g * 64, d0, d1, d2, d3);
            const float dist = (float)(t - pos);
            s_sc[0][j] = d0 - sl0 * dist; s_sc[1][j] = d1 - sl1 * dist; s_sc[2][j] = d2 - sl2 * dist; s_sc[3][j] = d3 - sl3 * dist;
        } else { s_sc[0][j] = -INFINITY; s_sc[1][j] = -INFINITY; s_sc[2][j] = -INFINITY; s_sc[3][j] = -INFINITY; }
    }
    __syncthreads();
    softmax4(s_sc, 512, lane);
    __syncthreads();
    {
        float o0 = 0.f, o1 = 0.f, o2 = 0.f, o3 = 0.f;
        const int j0 = t >= 511 ? 0 : 511 - t;
        for (int j = j0; j < 512; ++j) { const float v = bf2f(proj[(size_t)(b * T_ + t - 511 + j) * NP + PC_VW + g * 64 + lane]); o0 += s_sc[0][j] * v; o1 += s_sc[1][j] * v; o2 += s_sc[2][j] * v; o3 += s_sc[3][j] * v; }
        s_o[2][0][lane] = o0; s_o[2][1][lane] = o1; s_o[2][2][lane] = o2; s_o[2][3][lane] = o3;
    }
    __syncthreads();
    for (int h = 0; h < 4; ++h) {
        const int hd = g * 4 + h;
        const float g0 = sigmoid_f(bf2f(prow[PC_GL + 0 * 8 + hd]) + b_gate[0 * 8 + hd]);
        const float g1 = sigmoid_f(bf2f(prow[PC_GL + 1 * 8 + hd]) + b_gate[1 * 8 + hd]);
        const float g2 = sigmoid_f(bf2f(prow[PC_GL + 2 * 8 + hd]) + b_gate[2 * 8 + hd]);
        const float o = g0 * s_o[0][h][lane] + g1 * s_o[1][h][lane] + g2 * s_o[2][h][lane];
        const float ng = bf2f(prow[PC_NG + hd * 64 + lane]);
        Y[(size_t)m * D_ + 256 + hd * 64 + lane] = f2bf(o * silu_f(ng));
    }
}

__global__ __launch_bounds__(64) void k_mem_naive(const bf16_t* __restrict__ proj, const bf16_t* __restrict__ mkv, bf16_t* __restrict__ Y) {
    __shared__ float s_q[64];
    __shared__ float s_p[256];
    const int lane = threadIdx.x, hd = blockIdx.x & 3, m = blockIdx.x >> 2, b = m / T_;
    const bf16_t* prow = proj + (size_t)m * NP;
    s_q[lane] = bf2f(prow[PC_MQ + hd * 64 + lane]);
    __syncthreads();
    const bf16_t* kb = mkv + (size_t)(b * NMEM) * 512 + hd * 64;
    float sc[4], mx = -INFINITY;
#pragma unroll
    for (int u = 0; u < 4; ++u) {
        const int key = u * 64 + lane; float dot = 0.f;
        for (int d = 0; d < 64; ++d) dot += s_q[d] * bf2f(kb[(size_t)key * 512 + d]);
        sc[u] = dot; mx = fmaxf(mx, dot);
    }
    mx = wave_max(mx);
    float sum = 0.f;
#pragma unroll
    for (int u = 0; u < 4; ++u) { sc[u] = exp2f(sc[u] - mx); sum += sc[u]; s_p[u * 64 + lane] = sc[u]; }
    sum = wave_sum(sum);
    __syncthreads();
    float o = 0.f;
    for (int key = 0; key < 256; ++key) o += s_p[key] * bf2f(kb[(size_t)key * 512 + 256 + lane]);
    o /= sum;
    Y[(size_t)m * D_ + 768 + hd * 64 + lane] = f2bf(o * silu_f(bf2f(prow[PC_MG + hd * 64 + lane])));
}

__global__ __launch_bounds__(256) void k_conv(const bf16_t* __restrict__ proj, const float* __restrict__ cw, const float* __restrict__ cb, bf16_t* __restrict__ Y) {
    const int m = blockIdx.x, c = threadIdx.x, t = m % T_;
    const bf16_t* p = proj + (size_t)m * NP;
    float acc = cb[c];
#pragma unroll
    for (int k = 0; k < 3; ++k) {
        const int tt = t - 2 + k;
        if (tt >= 0) { const bf16_t* pp = p - (size_t)(2 - k) * NP; acc += cw[k * 256 + c] * bf2f(pp[PC_CC + c]) * bf2f(pp[PC_CH + c]); }
    }
    Y[(size_t)m * D_ + c] = f2bf(bf2f(p[PC_CB + c]) * acc * silu_f(bf2f(p[PC_CG + c])));
}

__global__ __launch_bounds__(256) void k_resid(const float* __restrict__ z, const float* xin, const float* __restrict__ gpost, const float* __restrict__ gpre_next, float* xout, bf16_t* __restrict__ xn) {
    const int row = blockIdx.x * 4 + (threadIdx.x >> 6), lane = threadIdx.x & 63;
    const float4* zr = (const float4*)(z + (size_t)row * D_);
    const float4* xr = (const float4*)(xin + (size_t)row * D_);
    float4 v[4]; float s = 0.f;
#pragma unroll
    for (int j = 0; j < 4; ++j) { v[j] = zr[lane + 64 * j]; s += v[j].x * v[j].x + v[j].y * v[j].y + v[j].z * v[j].z + v[j].w * v[j].w; }
    const float r = rsqrtf(wave_sum(s) * (1.f / D_) + EPS);
    float s2 = 0.f;
#pragma unroll
    for (int j = 0; j < 4; ++j) {
        const float4 gg = ((const float4*)gpost)[lane + 64 * j]; const float4 xx = xr[lane + 64 * j];
        v[j].x = xx.x + v[j].x * r * gg.x; v[j].y = xx.y + v[j].y * r * gg.y; v[j].z = xx.z + v[j].z * r * gg.z; v[j].w = xx.w + v[j].w * r * gg.w;
        s2 += v[j].x * v[j].x + v[j].y * v[j].y + v[j].z * v[j].z + v[j].w * v[j].w;
        ((float4*)(xout + (size_t)row * D_))[lane + 64 * j] = v[j];
    }
    if (gpre_next) {
        const float r2 = rsqrtf(wave_sum(s2) * (1.f / D_) + EPS);
#pragma unroll
        for (int j = 0; j < 4; ++j) {
            const float4 gg = ((const float4*)gpre_next)[lane + 64 * j];
            bf16_t* o = xn + (size_t)row * D_ + (lane + 64 * j) * 4;
            o[0] = f2bf(v[j].x * r2 * gg.x); o[1] = f2bf(v[j].y * r2 * gg.y); o[2] = f2bf(v[j].z * r2 * gg.z); o[3] = f2bf(v[j].w * r2 * gg.w);
        }
    }
}


__device__ __forceinline__ int tid_opaque() { int t = threadIdx.x; asm volatile("" : "+v"(t)); return t; }
__device__ __forceinline__ int bid_opaque() { int t = blockIdx.x; asm volatile("" : "+s"(t)); return t; }

namespace pg8 {
#define PG8_LAS __attribute__((address_space(3)))
typedef unsigned short bf16_t;
typedef short bf16x8 __attribute__((ext_vector_type(8)));
typedef float f32x4 __attribute__((ext_vector_type(4)));
typedef unsigned u32x4 __attribute__((ext_vector_type(4)));
constexpr int BM = 256, BK = 64, HALF = 128, HTB = HALF * BK * 2  , STAGE_BYTES = 8 * HTB, NXCD = 8, WGM = 8;

__host__ __device__ __forceinline__ int lds_byte(int r, int c) { const int st = (r >> 4) * 2 + (c >> 5), rr = r & 15, cc = c & 31, ob = rr * 64 + cc * 2; return st * 1024 + (ob ^ (((ob >> 9) & 1) << 5)); }
__host__ __device__ __forceinline__ void stage_rc(int b, int& R, int& C) { const int st = b / 1024, sb = b % 1024, swz = sb ^ (((sb >> 9) & 1) << 5); R = (st >> 1) * 16 + swz / 64; C = (st & 1) * 32 + (swz % 64) / 2; }
__host__ __device__ __forceinline__ int perm32(int rho) { const int n = rho >> 4, i = rho & 15; return 8 * (i >> 2) + 4 * n + (i & 3); }

struct Unit { int pm, pn; };
struct Gemm { const bf16_t* A; const bf16_t* Bt; int M, N, K; };

struct StaticOrder {
    int nM, nN, nwg, G, c;
    __host__ __device__ void init(int M, int N, int G_, int c_) { nM = M / BM; nN = N / BM; nwg = nM * nN; G = G_; c = c_; }
    __host__ __device__ bool next(int i, Unit& u) const {
        const long L = (long)i * G + c; if (L >= nwg) return false;
        int wgid = (int)L; { const int q = nwg / NXCD, r = nwg % NXCD, xcd = wgid % NXCD, off = wgid / NXCD; wgid = (xcd < r ? xcd * (q + 1) : r * (q + 1) + (xcd - r) * q) + off; }
        const int nig = WGM * nN, gid = wgid / nig, fm = gid * WGM, gsz = (nM - fm) < WGM ? (nM - fm) : WGM;
        u.pm = fm + ((wgid % nig) % gsz); u.pn = (wgid % nig) / gsz; return true;
    }
    __device__ __forceinline__ void a_ready(const Unit&) const {}
    __device__ __forceinline__ void done(const Unit&) const {}
};


__device__ __forceinline__ unsigned cvt_pk_bf16(float lo, float hi) { unsigned r; asm volatile("v_cvt_pk_bf16_f32 %0, %1, %2" : "=v"(r) : "v"(lo), "v"(hi)); return r; }

template <class Epi, class Sched, bool ALIGN_EPI = false, bool SP2 = false>
__device__ __forceinline__ void gemm_phase(PG8_LAS unsigned char* lds, const Gemm g, const Sched& S, const Epi& E) {
    const int tid = tid_opaque(), wid = __builtin_amdgcn_readfirstlane(tid >> 6), lane = tid & 63, wr = wid >> 2, wc = wid & 3, fr = lane & 15, fq = lane >> 4;
    const int K = g.K, nt = K / BK;
    unsigned voffA[2], voffB[2];
#pragma unroll
    for (int i = 0; i < 2; ++i) { int R, C; stage_rc(tid * 16 + i * 8192, R, C); const int Rb = Epi::PERM ? ((R & ~31) + perm32(R & 31)) : R;
        voffA[i] = (unsigned)(R * K + C) * 2u; voffB[i] = (unsigned)(Rb * K + C) * 2u; }
    const size_t kstep = (size_t)(BK * 2);
    const size_t hstep = (size_t)HALF * K * 2;
    const size_t tstep = 2 * hstep;
    const unsigned ldsw = (unsigned)wid * 1024u;
    const int aoff = lds_byte(wr * 64 + fr, fq * 8), boff = lds_byte(wc * 32 + fr, fq * 8);
#define PG8_SA(b, h) (((b) * 2 + (h)) * HTB)
#define PG8_SB(b, h) ((4 + (b) * 2 + (h)) * HTB)
#define PG8_STAGE(bufoff, gbase, voff) do { _Pragma("unroll") for (int _i = 0; _i < 2; ++_i) \
        __builtin_amdgcn_global_load_lds((const unsigned*)((const char*)(gbase) + (voff)[_i]), (PG8_LAS unsigned*)(lds + (bufoff) + ldsw + _i * 8192), 16, 0, 0); } while (0)
#define PG8_LDA(dst, b, h) do { _Pragma("unroll") for (int m = 0; m < 4; ++m) _Pragma("unroll") for (int k = 0; k < 2; ++k) dst[m][k] = *(const PG8_LAS bf16x8*)(lds + PG8_SA(b, h) + aoff + m * 2048 + k * 1024); } while (0)
#define PG8_LDB(dst, b, h) do { _Pragma("unroll") for (int n = 0; n < 2; ++n) _Pragma("unroll") for (int k = 0; k < 2; ++k) dst[n][k] = *(const PG8_LAS bf16x8*)(lds + PG8_SB(b, h) + boff + n * 2048 + k * 1024); } while (0)
#define PG8_MMA(ai, bj, At, Bt) do { __builtin_amdgcn_s_setprio(1); _Pragma("unroll") for (int m = 0; m < 4; ++m) _Pragma("unroll") for (int n = 0; n < 2; ++n) _Pragma("unroll") for (int k = 0; k < 2; ++k) \
        acc[ai][bj][m][n] = __builtin_amdgcn_mfma_f32_16x16x32_bf16(Bt[n][k], At[m][k], acc[ai][bj][m][n], 0, 0, 0); __builtin_amdgcn_s_setprio(0); } while (0)
#define PG8_WAIT_V(n) asm volatile("s_waitcnt vmcnt(" #n ")" ::: "memory")
#define PG8_WAIT_L(n) asm volatile("s_waitcnt lgkmcnt(" #n ")" ::: "memory")
#define PG8_BAR __builtin_amdgcn_s_barrier()
#define PG8_SCHED __builtin_amdgcn_sched_barrier(0)
    Unit cur, nxt; int ui = 0;
    if (!S.next(0, cur)) return;
    f32x4 acc[2][2][4][2];
#pragma unroll
    for (int a = 0; a < 2; ++a)
#pragma unroll
        for (int b = 0; b < 2; ++b)
#pragma unroll
            for (int m = 0; m < 4; ++m)
#pragma unroll
                for (int n = 0; n < 2; ++n) acc[a][b][m][n] = (f32x4){0.f, 0.f, 0.f, 0.f};
    bf16x8 At[4][2], B0[2][2], B1[2][2];
    const char* cA = (const char*)g.A + (size_t)cur.pm * tstep; const char* cB = (const char*)g.Bt + (size_t)cur.pn * tstep;
    S.a_ready(cur);
    if constexpr (SP2) {
        PG8_STAGE(PG8_SB(0, 0), cB, voffB); PG8_STAGE(PG8_SB(0, 1), cB + hstep, voffB); PG8_STAGE(PG8_SA(0, 0), cA, voffA); PG8_STAGE(PG8_SA(0, 1), cA + hstep, voffA);
        if (wr == 1) PG8_BAR;
        PG8_WAIT_V(2); PG8_BAR;
        PG8_STAGE(PG8_SB(1, 0), cB + kstep, voffB); PG8_STAGE(PG8_SA(1, 0), cA + kstep, voffA); PG8_STAGE(PG8_SB(1, 1), cB + hstep + kstep, voffB);
        PG8_WAIT_V(6); PG8_BAR;
    } else {
        PG8_STAGE(PG8_SB(0, 0), cB, voffB); PG8_STAGE(PG8_SA(0, 0), cA, voffA); PG8_STAGE(PG8_SB(0, 1), cB + hstep, voffB); PG8_STAGE(PG8_SA(0, 1), cA + hstep, voffA);
        if (wr == 1) PG8_BAR;
        PG8_WAIT_V(4); PG8_BAR;
        PG8_STAGE(PG8_SB(1, 0), cB + kstep, voffB); PG8_STAGE(PG8_SA(1, 0), cA + kstep, voffA); PG8_STAGE(PG8_SB(1, 1), cB + hstep + kstep, voffB);
        PG8_WAIT_V(6); PG8_BAR;
    }
    for (;;) {
        const bool has_next = S.next(ui + 1, nxt);
        const char* nA = has_next ? (const char*)g.A + (size_t)nxt.pm * tstep : cA; const char* nB = has_next ? (const char*)g.Bt + (size_t)nxt.pn * tstep : cB;
        for (int t = 0; t < nt; t += 2) {
            const bool last = (t == nt - 2);
            const char* a1 = cA + (size_t)(t + 1) * kstep;
            const char* a2 = last ? nA : cA + (size_t)(t + 2) * kstep; const char* b2 = last ? nB : cB + (size_t)(t + 2) * kstep;
            const char* a3 = a2 + kstep; const char* b3 = b2 + kstep;
            if (last && has_next) S.a_ready(nxt);
            if constexpr (SP2) {
            PG8_LDB(B0, 0, 0); PG8_LDB(B1, 0, 1); PG8_SCHED; PG8_LDA(At, 0, 0); PG8_STAGE(PG8_SA(1, 1), a1 + hstep, voffA);
            PG8_WAIT_V(8); PG8_WAIT_L(0); PG8_BAR; PG8_MMA(0, 0, At, B0); PG8_MMA(0, 1, At, B1); PG8_BAR; PG8_SCHED;
            PG8_LDA(At, 0, 1); PG8_STAGE(PG8_SB(0, 0), b2, voffB); PG8_STAGE(PG8_SB(0, 1), b2 + hstep, voffB); PG8_STAGE(PG8_SA(0, 0), a2, voffA);
            PG8_WAIT_V(8); PG8_WAIT_L(0); PG8_BAR; PG8_MMA(1, 0, At, B0); PG8_MMA(1, 1, At, B1); PG8_BAR; PG8_SCHED;
            PG8_LDB(B0, 1, 0); PG8_LDB(B1, 1, 1); PG8_SCHED; PG8_LDA(At, 1, 0); PG8_STAGE(PG8_SA(0, 1), a2 + hstep, voffA);
            PG8_WAIT_V(8); PG8_WAIT_L(0); PG8_BAR; PG8_MMA(0, 0, At, B0); PG8_MMA(0, 1, At, B1); PG8_BAR; PG8_SCHED;
            PG8_LDA(At, 1, 1); PG8_STAGE(PG8_SB(1, 0), b3, voffB); PG8_STAGE(PG8_SB(1, 1), b3 + hstep, voffB); PG8_STAGE(PG8_SA(1, 0), a3, voffA);
            PG8_WAIT_V(8); PG8_WAIT_L(0); PG8_BAR; PG8_MMA(1, 0, At, B0); PG8_MMA(1, 1, At, B1); PG8_BAR; PG8_SCHED;
            } else {
            PG8_LDB(B0, 0, 0); PG8_SCHED; PG8_LDA(At, 0, 0); PG8_STAGE(PG8_SA(1, 1), a1 + hstep, voffA);
            PG8_WAIT_L(8); PG8_BAR; PG8_WAIT_L(0); PG8_MMA(0, 0, At, B0); PG8_BAR; PG8_SCHED;
            PG8_LDB(B1, 0, 1); PG8_STAGE(PG8_SB(0, 0), b2, voffB);
            PG8_BAR; PG8_WAIT_L(0); PG8_MMA(0, 1, At, B1); PG8_BAR;
            PG8_LDA(At, 0, 1); PG8_STAGE(PG8_SA(0, 0), a2, voffA);
            PG8_BAR; PG8_WAIT_L(0); PG8_MMA(1, 0, At, B0); PG8_BAR; PG8_SCHED;
            PG8_STAGE(PG8_SB(0, 1), b2 + hstep, voffB);
            PG8_WAIT_V(6); PG8_BAR; PG8_MMA(1, 1, At, B1); PG8_BAR;
            PG8_LDB(B0, 1, 0); PG8_SCHED; PG8_LDA(At, 1, 0); PG8_STAGE(PG8_SA(0, 1), a2 + hstep, voffA);
            PG8_WAIT_L(8); PG8_BAR; PG8_WAIT_L(0); PG8_MMA(0, 0, At, B0); PG8_BAR; PG8_SCHED;
            PG8_LDB(B1, 1, 1); PG8_STAGE(PG8_SB(1, 0), b3, voffB);
            PG8_BAR; PG8_WAIT_L(0); PG8_MMA(0, 1, At, B1); PG8_BAR;
            PG8_LDA(At, 1, 1); PG8_STAGE(PG8_SA(1, 0), a3, voffA);
            PG8_BAR; PG8_WAIT_L(0); PG8_MMA(1, 0, At, B0); PG8_BAR; PG8_SCHED;
            PG8_STAGE(PG8_SB(1, 1), b3 + hstep, voffB);
            PG8_WAIT_V(6); PG8_BAR; PG8_MMA(1, 1, At, B1); PG8_BAR;
            }
        }
        if constexpr (ALIGN_EPI) { if (wr == 0) PG8_BAR; }
        if constexpr (!Epi::AFTER_DRAIN) { E(acc, cur, wr, wc, fr, fq); S.done(cur); }
        if (!has_next) break;
#pragma unroll
        for (int a = 0; a < 2; ++a)
#pragma unroll
            for (int b = 0; b < 2; ++b)
#pragma unroll
                for (int m = 0; m < 4; ++m)
#pragma unroll
                    for (int n = 0; n < 2; ++n) acc[a][b][m][n] = (f32x4){0.f, 0.f, 0.f, 0.f};
        cur = nxt; cA = nA; cB = nB; ++ui;
        if constexpr (ALIGN_EPI) { if (wr == 1) PG8_BAR; }
    }
    PG8_WAIT_V(0);
    if constexpr (!ALIGN_EPI) { if (wr == 0) PG8_BAR; }
    PG8_BAR;
    if constexpr (Epi::AFTER_DRAIN) { E.fused(acc, cur, wr, wc, fr, fq, lds, wid, lane); S.done(cur); }
#undef PG8_SA
#undef PG8_SB
#undef PG8_STAGE
#undef PG8_LDA
#undef PG8_LDB
#undef PG8_MMA
#undef PG8_WAIT_V
#undef PG8_WAIT_L
#undef PG8_BAR
#undef PG8_SCHED
}
}

namespace pg8 {
struct EpiProjF {
    static constexpr bool PERM = true, AFTER_DRAIN = false;
    bf16_t* proj; bf16_t* cmpb;
    __device__ __forceinline__ void operator()(const f32x4 (&acc)[2][2][4][2], const Unit& u, int wr, int wc, int fr, int fq) const {
        const int row0 = u.pm * BM + wr * 64 + fr, colb = u.pn * BM + wc * 32 + 8 * fq;
        const bool iscmp = (u.pn == 6);
#pragma unroll
        for (int ai = 0; ai < 2; ++ai)
#pragma unroll
            for (int m = 0; m < 4; ++m) {
                const int row = row0 + ai * HALF + m * 16;
#pragma unroll
                for (int bj = 0; bj < 2; ++bj) {
                    const f32x4 v0 = acc[ai][bj][m][0], v1 = acc[ai][bj][m][1];
                    u32x4 w; w.x = cvt_pk_bf16(v0[0], v0[1]); w.y = cvt_pk_bf16(v0[2], v0[3]); w.z = cvt_pk_bf16(v1[0], v1[1]); w.w = cvt_pk_bf16(v1[2], v1[3]);
                    const int col = colb + bj * HALF;
                    bf16_t* dst;
                    if (iscmp) { const int c = col - PC_KC, kv = c >> 7, g = (c >> 6) & 1, d = c & 63, b = row >> 13, t = row & (T_ - 1);
                                 dst = cmpb + ((size_t)((kv * B_ + b) * 2 + g) * T_ + t) * 64 + d; }
                    else dst = proj + (size_t)row * NP + col;
                    *(u32x4*)dst = w;
                }
            }
    }
};
struct EpiZF {
    static constexpr bool PERM = true, AFTER_DRAIN = false;
    float* z;
    __device__ __forceinline__ void operator()(const f32x4 (&acc)[2][2][4][2], const Unit& u, int wr, int wc, int fr, int fq) const {
        const int row0 = u.pm * BM + wr * 64 + fr, colb = u.pn * BM + wc * 32 + 8 * fq;
#pragma unroll
        for (int ai = 0; ai < 2; ++ai)
#pragma unroll
            for (int m = 0; m < 4; ++m) {
                float* rp = z + (size_t)(row0 + ai * HALF + m * 16) * D_ + colb;
#pragma unroll
                for (int bj = 0; bj < 2; ++bj) { *(f32x4*)(rp + bj * HALF) = acc[ai][bj][m][0]; *(f32x4*)(rp + bj * HALF + 4) = acc[ai][bj][m][1]; }
            }
    }
};
struct EpiMkvF {
    static constexpr bool PERM = true, AFTER_DRAIN = false;
    bf16_t* o;
    __device__ __forceinline__ void operator()(const f32x4 (&acc)[2][2][4][2], const Unit& u, int wr, int wc, int fr, int fq) const {
        const int row0 = u.pm * BM + wr * 64 + fr, colb = u.pn * BM + wc * 32 + 8 * fq;
#pragma unroll
        for (int ai = 0; ai < 2; ++ai)
#pragma unroll
            for (int m = 0; m < 4; ++m) {
                bf16_t* rp = o + (size_t)(row0 + ai * HALF + m * 16) * 512 + colb;
#pragma unroll
                for (int bj = 0; bj < 2; ++bj) { const f32x4 v0 = acc[ai][bj][m][0], v1 = acc[ai][bj][m][1];
                    u32x4 w; w.x = cvt_pk_bf16(v0[0], v0[1]); w.y = cvt_pk_bf16(v0[2], v0[3]); w.z = cvt_pk_bf16(v1[0], v1[1]); w.w = cvt_pk_bf16(v1[2], v1[3]);
                    *(u32x4*)(rp + bj * HALF) = w; }
            }
    }
};
}

namespace cmpf {
#define CLAS __attribute__((address_space(3)))
typedef short bf16x8 __attribute__((ext_vector_type(8)));
typedef float f32x16 __attribute__((ext_vector_type(16)));
typedef unsigned u32x4 __attribute__((ext_vector_type(4)));
constexpr int LA = 0, LB = 8192, LH = 8192 + 65536, L_BYTES = LH + 16384;
__device__ __forceinline__ void compress_unit(CLAS unsigned char* lds, int& par, const bf16_t* __restrict__ cmpb, const bf16_t* __restrict__ w1img, const float* __restrict__ cb1,
                                              const bf16_t* __restrict__ w2t, bf16_t* __restrict__ kvc, int kv, int bg, int rt, int tid) {
    const int lane = tid & 63, wave = __builtin_amdgcn_readfirstlane(tid >> 6), r32 = lane & 31, hi = lane >> 5;
    const int i0 = 32 * rt;
    const bf16_t* asrc = cmpb + ((size_t)(kv * 8 + bg) * T_ + 16 * (size_t)(i0 + (tid & 31))) * 64 + (tid >> 5) * 8;
    const bf16_t* bsrc = w1img + (size_t)tid * 8;
    f32x16 acc;
#pragma unroll
    for (int r = 0; r < 16; ++r) acc[r] = 0.f;
    u32x4 ra, rb[4];
    if (tid < 256) ra = *(const u32x4*)(asrc);
#pragma unroll
    for (int j = 0; j < 4; ++j) rb[j] = *(const u32x4*)(bsrc + j * 4096);
    for (int kk = 0; kk < 32; ++kk) {
        CLAS unsigned char* la = lds + LA + par * 4096; CLAS unsigned char* lb = lds + LB + par * 32768;
        if (tid < 256) *(CLAS u32x4*)(la + tid * 16) = ra;
#pragma unroll
        for (int j = 0; j < 4; ++j) *(CLAS u32x4*)(lb + (j * 512 + tid) * 16) = rb[j];
        if (kk + 1 < 32) {
            if (tid < 256) ra = *(const u32x4*)(asrc + (kk + 1) * 64);
#pragma unroll
            for (int j = 0; j < 4; ++j) rb[j] = *(const u32x4*)(bsrc + (size_t)(kk + 1) * 16384 + j * 4096);
        }
        __syncthreads();
#pragma unroll
        for (int ds = 0; ds < 4; ++ds) {
            const bf16x8 a = *(const CLAS bf16x8*)(la + (2 * ds + hi) * 512 + r32 * 16);
            const bf16x8 bfr = *(const CLAS bf16x8*)(lb + (2 * ds + hi) * 4096 + (32 * wave + r32) * 16);
            acc = __builtin_amdgcn_mfma_f32_32x32x16_bf16(a, bfr, acc, 0, 0, 0);
        }
        par ^= 1;
    }
    {
        const int n = 32 * wave + r32; const float bias = cb1[n];
        CLAS bf16_t* H = (CLAS bf16_t*)(lds + LH);
#pragma unroll
        for (int r = 0; r < 16; ++r) {
            const int row = (r & 3) + 8 * (r >> 2) + 4 * hi;
            const float x = acc[r] + bias;
            const float u2 = 2.f * 0.7978845608028654f * (x + 0.044715f * x * x * x);
            const float gl = x / (1.f + __builtin_amdgcn_exp2f(-u2 * LOG2E));
            H[(n >> 3) * 256 + row * 8 + (n & 7)] = f2bf(gl);
        }
    }
    __syncthreads();
    if (wave < 2) {
        f32x16 a2;
#pragma unroll
        for (int r = 0; r < 16; ++r) a2[r] = 0.f;
#pragma unroll
        for (int ks = 0; ks < 16; ++ks) {
            const bf16x8 a = *(const CLAS bf16x8*)(lds + LH + (2 * ks + hi) * 512 + r32 * 16);
            const bf16x8 bfr = *(const bf16x8*)(w2t + (size_t)(32 * wave + r32) * 256 + 16 * ks + 8 * hi);
            a2 = __builtin_amdgcn_mfma_f32_32x32x16_bf16(a, bfr, a2, 0, 0, 0);
        }
#pragma unroll
        for (int r = 0; r < 16; ++r) {
            const int i = i0 + (r & 3) + 8 * (r >> 2) + 4 * hi;
            kvc[((size_t)(kv * 8 + bg) * 512 + i) * 64 + 32 * wave + r32] = i == 511 ? (bf16_t)0 : f2bf(a2[r]);
        }
    }
    __syncthreads();
}
__device__ __forceinline__ void compress_phase(CLAS unsigned char* lds, const bf16_t* cmpb, const bf16_t* w1img, const float* cb1, const bf16_t* w2t, bf16_t* kvc) {
    int par = 0;
    const int tid = tid_opaque(), bid = bid_opaque();
    for (int u = bid; u < 256; u += gridDim.x) {
        const int kv = u >> 7, bg = (u >> 4) & 7, rt = u & 15;
        compress_unit(lds, par, cmpb, w1img + (size_t)kv * 524288, cb1 + kv * 256, w2t + (size_t)kv * 16384, kvc, kv, bg, rt, tid);
    }
}
}

namespace misc {
#define MLAS __attribute__((address_space(3)))
typedef unsigned u32x4 __attribute__((ext_vector_type(4)));
__device__ __forceinline__ unsigned pk2(float lo, float hi) { return (unsigned)f2bf(lo) | ((unsigned)f2bf(hi) << 16); }
template <int MODE>
__device__ __forceinline__ void transpose_item(const float* __restrict__ W, int ldsrc, int K, int N, bf16_t* __restrict__ dst, MLAS float* scr, int item, int lane) {
    const int nblk = N / 32, kb = item / nblk, nb = item % nblk, k0 = 64 * kb, n0 = 32 * nb;
    const int n = n0 + (lane & 31);
    int sc = n; float scale = 1.f;
    if (MODE == 1) { sc = orig_col(n); if ((n >= PC_Q && n < PC_Q + 512) || (n >= PC_MQ && n < PC_MQ + 256)) scale = C2; }
#pragma unroll 8
    for (int i = 0; i < 32; ++i) { const int kk = 2 * i + (lane >> 5); scr[kk * 33 + (lane & 31)] = sc >= 0 ? W[(size_t)(k0 + kk) * ldsrc + sc] * scale : 0.f; }
    asm volatile("s_waitcnt lgkmcnt(0)" ::: "memory");
    const int c = lane & 7;
#pragma unroll
    for (int j = 0; j < 4; ++j) {
        const int nn = (lane >> 3) + 8 * j; const MLAS float* s = scr + (8 * c) * 33 + nn;
        u32x4 o; o.x = pk2(s[0 * 33], s[1 * 33]); o.y = pk2(s[2 * 33], s[3 * 33]); o.z = pk2(s[4 * 33], s[5 * 33]); o.w = pk2(s[6 * 33], s[7 * 33]);
        bf16_t* d = MODE == 2 ? dst + ((size_t)((k0 >> 6) * 8 + c) * N + (n0 + nn)) * 8 : dst + (size_t)(n0 + nn) * K + k0 + 8 * c;
        *(u32x4*)d = o;
    }
    asm volatile("s_waitcnt lgkmcnt(0)" ::: "memory");
}
__device__ __forceinline__ void rms_row(const float* __restrict__ xrow, const float* __restrict__ g, bf16_t* __restrict__ orow, int lane) {
    const float4* xr = (const float4*)xrow;
    float4 v[4]; float s = 0.f;
#pragma unroll
    for (int j = 0; j < 4; ++j) { v[j] = xr[lane + 64 * j]; s += v[j].x * v[j].x + v[j].y * v[j].y + v[j].z * v[j].z + v[j].w * v[j].w; }
    const float r = rsqrtf(wave_sum(s) * (1.f / D_) + EPS);
#pragma unroll
    for (int j = 0; j < 4; ++j) {
        const float4 gg = ((const float4*)g)[lane + 64 * j];
        uint2 o; o.x = pk2(v[j].x * r * gg.x, v[j].y * r * gg.y); o.y = pk2(v[j].z * r * gg.z, v[j].w * r * gg.w);
        *(uint2*)(orow + (lane + 64 * j) * 4) = o;
    }
}
__device__ __forceinline__ void resid_row(const float* zrow, const float* xrow, const float* __restrict__ gpost, const float* __restrict__ gnext, float* xorow, bf16_t* xnrow, int lane) {
    const float4* zr = (const float4*)zrow; const float4* xr = (const float4*)xrow;
    float4 v[4]; float s = 0.f;
#pragma unroll
    for (int j = 0; j < 4; ++j) { v[j] = zr[lane + 64 * j]; s += v[j].x * v[j].x + v[j].y * v[j].y + v[j].z * v[j].z + v[j].w * v[j].w; }
    const float r = rsqrtf(wave_sum(s) * (1.f / D_) + EPS);
    float s2 = 0.f;
#pragma unroll
    for (int j = 0; j < 4; ++j) {
        const float4 gg = ((const float4*)gpost)[lane + 64 * j]; const float4 xx = xr[lane + 64 * j];
        v[j].x = xx.x + v[j].x * r * gg.x; v[j].y = xx.y + v[j].y * r * gg.y; v[j].z = xx.z + v[j].z * r * gg.z; v[j].w = xx.w + v[j].w * r * gg.w;
        s2 += v[j].x * v[j].x + v[j].y * v[j].y + v[j].z * v[j].z + v[j].w * v[j].w;
        ((float4*)xorow)[lane + 64 * j] = v[j];
    }
    if (gnext) {
        const float r2 = rsqrtf(wave_sum(s2) * (1.f / D_) + EPS);
#pragma unroll
        for (int j = 0; j < 4; ++j) {
            const float4 gg = ((const float4*)gnext)[lane + 64 * j];
            uint2 o; o.x = pk2(v[j].x * r2 * gg.x, v[j].y * r2 * gg.y); o.y = pk2(v[j].z * r2 * gg.z, v[j].w * r2 * gg.w);
            *(uint2*)(xnrow + (lane + 64 * j) * 4) = o;
        }
    }
}
}

namespace att {
#define ALAS __attribute__((address_space(3)))
typedef short bf16x8 __attribute__((ext_vector_type(8)));
typedef short s16x4 __attribute__((ext_vector_type(4)));
typedef short v4i16_t __attribute__((ext_vector_type(4)));
typedef float f32x16 __attribute__((ext_vector_type(16)));
typedef float f32x4 __attribute__((ext_vector_type(4)));
typedef unsigned u32x4 __attribute__((ext_vector_type(4)));
typedef unsigned u32x2 __attribute__((ext_vector_type(2)));

constexpr int L_K = 0, L_V = 16384, L_IMP = 32768  , L_STG = 65536  ,
              L_WSF = 131072, L_MASK = 133120, L_WMASK = 134144, L_BYTES = 134272;

__device__ __forceinline__ unsigned cvtpk(float lo, float hi) {
    typedef float f2_t __attribute__((ext_vector_type(2))); typedef __bf16 b2_t __attribute__((ext_vector_type(2)));
    f2_t v = {lo, hi}; b2_t b = __builtin_convertvector(v, b2_t); return __builtin_bit_cast(unsigned, b);
}
__device__ __forceinline__ s16x4 vtr(const ALAS unsigned char* p) { return __builtin_bit_cast(s16x4, __builtin_amdgcn_ds_read_tr16_b64_v4i16((ALAS v4i16_t*)p)); }
__device__ __forceinline__ float dpp_xor1(float v) { return __builtin_bit_cast(float, __builtin_amdgcn_update_dpp(0, __builtin_bit_cast(int, v), 0xB1, 0xF, 0xF, true)); }
__device__ __forceinline__ float dpp_xor2(float v) { return __builtin_bit_cast(float, __builtin_amdgcn_update_dpp(0, __builtin_bit_cast(int, v), 0x4E, 0xF, 0xF, true)); }
__device__ __forceinline__ float swap32_max(float m) { auto rr = __builtin_amdgcn_permlane32_swap(__float_as_uint(m), __float_as_uint(m), false, false); return fmaxf(__uint_as_float(rr[0]), __uint_as_float(rr[1])); }
__device__ __forceinline__ float swap32_sum(float m) { auto rr = __builtin_amdgcn_permlane32_swap(__float_as_uint(m), __float_as_uint(m), false, false); return __uint_as_float(rr[0]) + __uint_as_float(rr[1]); }
__device__ __forceinline__ void wg_barrier() { __syncthreads(); }

struct WaveSt { bf16x8 qf[4]; f32x16 o0, o1; float m, l; };
struct TReg { u32x4 k, v; };

__device__ __forceinline__ void ld_k(TReg& R, const bf16_t* kp, int pitch, int wave, int lane) { R.k = *(const u32x4*)(kp + (size_t)lane * pitch + wave * 8); }
__device__ __forceinline__ void ld_v(TReg& R, const bf16_t* vp, int pitch, int wave, int lane) { R.v = *(const u32x4*)(vp + (size_t)(16 * (wave & 3) + (lane >> 2)) * pitch + (wave >> 2) * 32 + (lane & 3) * 8); }
__device__ __forceinline__ void st_k(const TReg& R, ALAS unsigned char* ks, int tid) { *(ALAS u32x4*)(ks + tid * 16) = R.k; }
__device__ __forceinline__ void st_v(const TReg& R, ALAS unsigned char* vs, int tid) { *(ALAS u32x4*)(vs + tid * 16) = R.v; }

template <int MODE, bool BIAS>
__device__ __forceinline__ void att_step(const ALAS unsigned char* Ks, const ALAS unsigned char* Vs, WaveSt& S, ALAS float* wsf, int lane, int r32, int hi,
                                         float slope2, int tq, int kstride, unsigned maxd, bool rowok, float inv_l, f32x16& p0, f32x16& p1) {
    if (BIAS) {
        const int tqh = tq - kstride * 4 * hi;
#pragma unroll
        for (int r = 0; r < 16; ++r) {
            const int cr = (r & 3) + 8 * (r >> 2);
            const int d0 = tqh - kstride * cr, d1 = d0 - kstride * 32;
            p0[r] = (rowok && (unsigned)d0 < maxd) ? -slope2 * (float)d0 : -INFINITY;
            p1[r] = (rowok && (unsigned)d1 < maxd) ? -slope2 * (float)d1 : -INFINITY;
        }
    } else {
#pragma unroll
        for (int r = 0; r < 16; ++r) { p0[r] = 0.f; p1[r] = 0.f; }
    }
    const ALAS unsigned char* kb = Ks + hi * 1024 + r32 * 16;
#pragma unroll
    for (int ds = 0; ds < 4; ++ds) {
        const bf16x8 a0 = *(const ALAS bf16x8*)(kb + ds * 2048), a1 = *(const ALAS bf16x8*)(kb + ds * 2048 + 512);
        p0 = __builtin_amdgcn_mfma_f32_32x32x16_bf16(a0, S.qf[ds], p0, 0, 0, 0);
        p1 = __builtin_amdgcn_mfma_f32_32x32x16_bf16(a1, S.qf[ds], p1, 0, 0, 0);
    }
    if (MODE == 2) {
#pragma unroll
        for (int r = 0; r < 16; ++r) { p0[r] = __builtin_amdgcn_exp2f(p0[r] - S.m) * inv_l; p1[r] = __builtin_amdgcn_exp2f(p1[r] - S.m) * inv_l; }
    } else {
        float mx = fmaxf(p0[0], p1[0]);
#pragma unroll
        for (int r = 1; r < 16; ++r) mx = fmaxf(mx, fmaxf(p0[r], p1[r]));
        mx = swap32_max(mx);
        const float mn = fmaxf(S.m, mx), alpha = __builtin_amdgcn_exp2f(S.m - mn);
        S.m = mn;
        float rs = 0.f;
#pragma unroll
        for (int r = 0; r < 16; ++r) { p0[r] = __builtin_amdgcn_exp2f(p0[r] - mn); p1[r] = __builtin_amdgcn_exp2f(p1[r] - mn); rs += p0[r] + p1[r]; }
        S.l = S.l * alpha + rs;
        if (MODE == 1) return;
        if (__any(alpha != 1.f)) {
            if (hi == 0) wsf[r32] = alpha;
#pragma unroll
            for (int a = 0; a < 4; ++a) {
                const f32x4 f = *(const ALAS f32x4*)(wsf + 8 * a + 4 * hi);
#pragma unroll
                for (int i = 0; i < 4; ++i) { S.o0[4 * a + i] *= f[i]; S.o1[4 * a + i] *= f[i]; }
            }
        }
    }
    u32x4 pw[4];
    pw[0] = (u32x4){cvtpk(p0[0], p0[1]), cvtpk(p0[2], p0[3]), cvtpk(p0[4], p0[5]), cvtpk(p0[6], p0[7])};
    pw[1] = (u32x4){cvtpk(p0[8], p0[9]), cvtpk(p0[10], p0[11]), cvtpk(p0[12], p0[13]), cvtpk(p0[14], p0[15])};
    pw[2] = (u32x4){cvtpk(p1[0], p1[1]), cvtpk(p1[2], p1[3]), cvtpk(p1[4], p1[5]), cvtpk(p1[6], p1[7])};
    pw[3] = (u32x4){cvtpk(p1[8], p1[9]), cvtpk(p1[10], p1[11]), cvtpk(p1[12], p1[13]), cvtpk(p1[14], p1[15])};
    const ALAS unsigned char* vb = Vs + ((lane >> 4) & 1) * 32 + (lane & 3) * 8 + (4 * hi + ((lane & 15) >> 2)) * 64;
#pragma unroll
    for (int ks = 0; ks < 4; ++ks) {
        const bf16x8 pa = __builtin_bit_cast(bf16x8, pw[ks]);
        const s16x4 l0 = vtr(vb + ks * 1024), h0 = vtr(vb + ks * 1024 + 512);
        const s16x4 l1 = vtr(vb + 4096 + ks * 1024), h1 = vtr(vb + 4096 + ks * 1024 + 512);
        const bf16x8 v0 = (bf16x8){l0[0], l0[1], l0[2], l0[3], h0[0], h0[1], h0[2], h0[3]};
        const bf16x8 v1 = (bf16x8){l1[0], l1[1], l1[2], l1[3], h1[0], h1[1], h1[2], h1[3]};
        S.o0 = __builtin_amdgcn_mfma_f32_32x32x16_bf16(pa, v0, S.o0, 0, 0, 0);
        S.o1 = __builtin_amdgcn_mfma_f32_32x32x16_bf16(pa, v1, S.o1, 0, 0, 0);
    }
}
template <bool FIRST>
__device__ __forceinline__ void fold(WaveSt& S, ALAS float* stg, float f_row, ALAS float* wsf, int r32, int hi) {
    if (hi == 0) wsf[r32] = f_row;
#pragma unroll
    for (int a = 0; a < 4; ++a) {
        const f32x4 f = *(const ALAS f32x4*)(wsf + 8 * a + 4 * hi);
#pragma unroll
        for (int i = 0; i < 4; ++i) {
            const int idx = (8 * a + 4 * hi + i) * 64 + r32;
            if (FIRST) { stg[idx] = S.o0[4 * a + i] * f[i]; stg[idx + 32] = S.o1[4 * a + i] * f[i]; }
            else { stg[idx] += S.o0[4 * a + i] * f[i]; stg[idx + 32] += S.o1[4 * a + i] * f[i]; }
        }
    }
#pragma unroll
    for (int r = 0; r < 16; ++r) { S.o0[r] = 0.f; S.o1[r] = 0.f; }
}

template <class RowMap>
__device__ __forceinline__ void store_rows(ALAS float* stg  , int lane, const RowMap& rm) {
#pragma unroll
    for (int i = 0; i < 4; ++i) {
        const int row = i * 8 + (lane >> 3), ch = lane & 7;
        const f32x4 a = *(const ALAS f32x4*)(stg + row * 64 + ch * 8), c = *(const ALAS f32x4*)(stg + row * 64 + ch * 8 + 4);
        const bf16_t* gp; bf16_t* yp; rm(row, gp, yp);
        const u32x4 gv = *(const u32x4*)(gp + ch * 8);
        const unsigned gw[4] = {gv.x, gv.y, gv.z, gv.w};
        const float ov[8] = {a[0], a[1], a[2], a[3], c[0], c[1], c[2], c[3]};
        unsigned ow[4];
#pragma unroll
        for (int j = 0; j < 4; ++j) {
            const float glo = __uint_as_float(gw[j] << 16), ghi = __uint_as_float(gw[j] & 0xffff0000u);
            ow[j] = cvtpk(ov[2 * j] * silu_f(glo), ov[2 * j + 1] * silu_f(ghi));
        }
        *(u32x4*)(yp + ch * 8) = (u32x4){ow[0], ow[1], ow[2], ow[3]};
    }
}

struct NsaRowMap { const bf16_t* proj; bf16_t* Y; int b, g, tbase;
    __device__ __forceinline__ void operator()(int row, const bf16_t*& gp, bf16_t*& yp) const {
        const size_t m = (size_t)b * T_ + tbase + (row >> 2); const int hd = g * 4 + (row & 3);
        gp = proj + m * NP + PC_NG + hd * 64; yp = Y + m * D_ + 256 + hd * 64; } };
struct MemRowMap { const bf16_t* proj; bf16_t* Y; int b, mh, tbase;
    __device__ __forceinline__ void operator()(int row, const bf16_t*& gp, bf16_t*& yp) const {
        const size_t m = (size_t)b * T_ + tbase + row;
        gp = proj + m * NP + PC_MG + mh * 64; yp = Y + m * D_ + 768 + mh * 64; } };

__device__ __forceinline__ void nsa_unit(ALAS unsigned char* lds, int& par, const bf16_t* __restrict__ proj, const bf16_t* __restrict__ kvc, const float* __restrict__ bgate, bf16_t* __restrict__ Y, int b, int g, int qb, int tid) {
    const int lane = tid & 63, wave = __builtin_amdgcn_readfirstlane(tid >> 6), r32 = lane & 31, hi = lane >> 5;
    const int q0 = qb * 64, qi = r32 >> 2, hh = r32 & 3, head = g * 4 + hh, t_row = q0 + 8 * wave + qi;
    const float slope2 = exp2f(-(float)(head + 1)) * LOG2E;
    const bf16_t* prow = proj + (size_t)(b * T_ + t_row) * NP;
    WaveSt S;
#pragma unroll
    for (int ds = 0; ds < 4; ++ds) S.qf[ds] = *(const bf16x8*)(prow + PC_Q + head * 64 + ds * 16 + hi * 8);
    const float g0 = sigmoid_f(bf2f(prow[PC_GL + head]) + bgate[head]);
    const float g1 = sigmoid_f(bf2f(prow[PC_GL + 8 + head]) + bgate[8 + head]);
    const float g2 = sigmoid_f(bf2f(prow[PC_GL + 16 + head]) + bgate[16 + head]);
    ALAS float* wsf = (ALAS float*)(lds + L_WSF) + wave * 64;
    ALAS float* imp = (ALAS float*)(lds + L_IMP) + wave * 1024;
    ALAS float* stg = (ALAS float*)(lds + L_STG) + wave * 2048;
    ALAS unsigned char* Kl = lds + L_K; ALAS unsigned char* Vl = lds + L_V;
    f32x16 p0, p1;
#pragma unroll
    for (int r = 0; r < 16; ++r) { S.o0[r] = 0.f; S.o1[r] = 0.f; }
    const bf16_t* kc = kvc + (size_t)((0 * B_ + b) * 2 + g) * 512 * 64;
    const bf16_t* vc = kvc + (size_t)((1 * B_ + b) * 2 + g) * 512 * 64;
    const int nvmax = min((q0 + 63 - 31) / 16 + 1, 511), ntc = (nvmax + 63) >> 6;
    TReg R;
    S.m = -1e30f; S.l = 0.f;
    ld_k(R, kc, 64, wave, lane);
    for (int jt = 0; jt < ntc; ++jt) {
        st_k(R, Kl + par * 8192, tid);
        if (jt + 1 < ntc) ld_k(R, kc + (size_t)(jt + 1) * 4096, 64, wave, lane);
        wg_barrier();
        att_step<1, true>(Kl + par * 8192, Vl, S, wsf, lane, r32, hi, slope2, t_row - (1024 * jt + 31), 16, 0x7fffffffu, true, 0.f, p0, p1);
        par ^= 1;
    }
    const float l_c = swap32_sum(S.l);
    const float inv_l = l_c > 0.f ? 1.f / l_c : 0.f;
    float carry = 0.f;
    ld_k(R, kc, 64, wave, lane); ld_v(R, vc, 64, wave, lane);
    for (int jt = 0; jt < ntc; ++jt) {
        st_k(R, Kl + par * 8192, tid); st_v(R, Vl + par * 8192, tid);
        if (jt + 1 < ntc) { ld_k(R, kc + (size_t)(jt + 1) * 4096, 64, wave, lane); ld_v(R, vc + (size_t)(jt + 1) * 4096, 64, wave, lane); }
        wg_barrier();
        att_step<2, true>(Kl + par * 8192, Vl + par * 8192, S, wsf, lane, r32, hi, slope2, t_row - (1024 * jt + 31), 16, 0x7fffffffu, true, inv_l, p0, p1);
        par ^= 1;
        {
            float Av[8], Bv[8];
#pragma unroll
            for (int u = 0; u < 2; ++u)
#pragma unroll
                for (int a = 0; a < 4; ++a) {
                    const float x0 = u ? p1[4 * a] : p0[4 * a], x1 = u ? p1[4 * a + 1] : p0[4 * a + 1], x2 = u ? p1[4 * a + 2] : p0[4 * a + 2], x3 = u ? p1[4 * a + 3] : p0[4 * a + 3];
                    float A = 2.f * (x0 + x1 + x2) + x3, B = x3;
                    A += dpp_xor1(A); A += dpp_xor2(A); B += dpp_xor1(B); B += dpp_xor2(B);
                    Av[u * 4 + a] = A; Bv[u * 4 + a] = B;
                }
            float prevB[8];
#pragma unroll
            for (int i = 0; i < 8; ++i) {
                const float mine_lo = Bv[i];
                const float mine_hi = i == 0 ? carry : Bv[i - 1];
                const float give = hi ? mine_hi : mine_lo;
                auto rr = __builtin_amdgcn_permlane32_swap(__float_as_uint(give), __float_as_uint(give), false, false);
                prevB[i] = __uint_as_float(hi ? rr[0] : rr[1]);
            }
            carry = Bv[7];
            if (hh == 0) {
#pragma unroll
                for (int i = 0; i < 8; ++i) imp[qi * 128 + 16 * jt + 8 * (i >> 2) + 2 * (i & 3) + hi] = Av[i] + prevB[i];
            }
        }
    }
    fold<true>(S, stg, g0, wsf, r32, hi);
    const int cur = qb;
    unsigned long long my_a, my_b, um_a = 0ull, um_b = 0ull;
    {
        const int ncand = cur >= 2 ? cur - 2 : 0, nforced = cur >= 2 ? 3 : cur + 1, need = 16 - nforced;
        unsigned long long fa = 1ull, fb = 0ull;
        if (cur < 64) fa |= 1ull << cur; else fb |= 1ull << (cur - 64);
        if (cur >= 1) { if (cur - 1 < 64) fa |= 1ull << (cur - 1); else fb |= 1ull << (cur - 65); }
        ALAS u32x4* selm = (ALAS u32x4*)(lds + L_MASK);
        if (ncand <= need) {
            const unsigned long long ma = cur >= 63 ? ~0ull : ((1ull << (cur + 1)) - 1ull);
            um_a = ma; um_b = 0ull;
            if (lane < 8) selm[8 * wave + lane] = (u32x4){(unsigned)ma, (unsigned)(ma >> 32), 0u, 0u};
        } else {
            const bool ca = lane >= 1 && lane <= cur - 2, cb = lane + 64 <= cur - 2;
            for (int q = 0; q < 8; ++q) {
                const unsigned ua = __float_as_uint(imp[q * 128 + lane]);
                const unsigned ub = __float_as_uint(imp[q * 128 + 64 + lane]);
                unsigned tau = 0u;
                for (int bit = 30; bit >= 0; --bit) {
                    const unsigned c = tau | (1u << bit);
                    const int cnt = __popcll(__ballot(ca && ua >= c)) + __popcll(__ballot(cb && ub >= c));
                    if (cnt >= need) tau = c;
                }
                unsigned long long ga = __ballot(ca && ua > tau), gb = __ballot(cb && ub > tau), ea = __ballot(ca && ua == tau), eb = __ballot(cb && ub == tau);
                int rem = need - __popcll(ga) - __popcll(gb);
                while (rem > 0 && ea) { ga |= ea & (0ull - ea); ea &= ea - 1ull; --rem; }
                while (rem > 0 && eb) { gb |= eb & (0ull - eb); eb &= eb - 1ull; --rem; }
                ga |= fa; gb |= fb;
                um_a |= ga; um_b |= gb;
                if (lane == 0) selm[8 * wave + q] = (u32x4){(unsigned)ga, (unsigned)(ga >> 32), (unsigned)gb, (unsigned)(gb >> 32)};
            }
        }
        if (lane == 0) ((ALAS u32x4*)(lds + L_WMASK))[wave] = (u32x4){(unsigned)um_a, (unsigned)(um_a >> 32), (unsigned)um_b, (unsigned)(um_b >> 32)};
        const u32x4 mm = selm[8 * wave + qi];
        my_a = (unsigned long long)mm.x | ((unsigned long long)mm.y << 32); my_b = (unsigned long long)mm.z | ((unsigned long long)mm.w << 32);
    }
    {
        const size_t kwo = (size_t)b * T_ * NP + PC_KW + g * 64, vwo = (size_t)b * T_ * NP + PC_VW + g * 64;
        const int wlo = qb >= 8 ? qb - 8 : 0;
        S.m = -1e30f; S.l = 0.f;
        ld_k(R, proj + kwo + (size_t)wlo * 64 * NP, NP, wave, lane); ld_v(R, proj + vwo + (size_t)wlo * 64 * NP, NP, wave, lane);
        for (int blk = wlo; blk <= qb; ++blk) {
            st_k(R, Kl + par * 8192, tid); st_v(R, Vl + par * 8192, tid);
            if (blk + 1 <= qb) { ld_k(R, proj + kwo + (size_t)(blk + 1) * 64 * NP, NP, wave, lane); ld_v(R, proj + vwo + (size_t)(blk + 1) * 64 * NP, NP, wave, lane); }
            wg_barrier();
            att_step<0, true>(Kl + par * 8192, Vl + par * 8192, S, wsf, lane, r32, hi, slope2, t_row - 64 * blk, 1, 512u, true, 0.f, p0, p1);
            par ^= 1;
        }
        const float l_w = swap32_sum(S.l);
        fold<false>(S, stg, g2 / l_w, wsf, r32, hi);
    }
    {
        unsigned long long ua = 0ull, ub = 0ull;
        {
            const ALAS u32x4* wm = (const ALAS u32x4*)(lds + L_WMASK);
#pragma unroll
            for (int w = 0; w < 8; ++w) { const u32x4 v = wm[w]; ua |= (unsigned long long)v.x | ((unsigned long long)v.y << 32); ub |= (unsigned long long)v.z | ((unsigned long long)v.w << 32); }
            ua = ((unsigned long long)__builtin_amdgcn_readfirstlane((unsigned)(ua >> 32)) << 32) | (unsigned)__builtin_amdgcn_readfirstlane((unsigned)ua);
            ub = ((unsigned long long)__builtin_amdgcn_readfirstlane((unsigned)(ub >> 32)) << 32) | (unsigned)__builtin_amdgcn_readfirstlane((unsigned)ub);
        }
        const size_t kso = (size_t)b * T_ * NP + PC_KS + g * 64, vso = (size_t)b * T_ * NP + PC_VS + g * 64;
        S.m = -1e30f; S.l = 0.f;
        int blk = ua ? __ffsll((long long)ua) - 1 : (ub ? 64 + __ffsll((long long)ub) - 1 : -1);
        if (blk >= 0) { if (blk < 64) ua &= ua - 1ull; else ub &= ub - 1ull; }
        if (blk >= 0) { ld_k(R, proj + kso + (size_t)blk * 64 * NP, NP, wave, lane); ld_v(R, proj + vso + (size_t)blk * 64 * NP, NP, wave, lane); }
        while (blk >= 0) {
            int nxt = ua ? __ffsll((long long)ua) - 1 : (ub ? 64 + __ffsll((long long)ub) - 1 : -1);
            if (nxt >= 0) { if (nxt < 64) ua &= ua - 1ull; else ub &= ub - 1ull; }
            st_k(R, Kl + par * 8192, tid); st_v(R, Vl + par * 8192, tid);
            if (nxt >= 0) { ld_k(R, proj + kso + (size_t)nxt * 64 * NP, NP, wave, lane); ld_v(R, proj + vso + (size_t)nxt * 64 * NP, NP, wave, lane); }
            wg_barrier();
            const bool wsel = blk < 64 ? ((um_a >> blk) & 1ull) : ((um_b >> (blk - 64)) & 1ull);
            if (wsel) {
                const bool rowok = blk < 64 ? ((my_a >> blk) & 1ull) : ((my_b >> (blk - 64)) & 1ull);
                att_step<0, true>(Kl + par * 8192, Vl + par * 8192, S, wsf, lane, r32, hi, slope2, t_row - 64 * blk, 1, 0x7fffffffu, rowok, 0.f, p0, p1);
            }
            par ^= 1;
            blk = nxt;
        }
        const float l_s = swap32_sum(S.l);
        fold<false>(S, stg, g1 / l_s, wsf, r32, hi);
    }
    store_rows(stg, lane, NsaRowMap{proj, Y, b, g, q0 + 8 * wave});
}

__device__ __forceinline__ void mem_unit(ALAS unsigned char* lds, int& par, const bf16_t* __restrict__ proj, const bf16_t* __restrict__ mkv, bf16_t* __restrict__ Y, int b, int mh, int qb, int tid) {
    const int lane = tid & 63, wave = __builtin_amdgcn_readfirstlane(tid >> 6), r32 = lane & 31, hi = lane >> 5;
    const int t_row = qb * 256 + 32 * wave + r32;
    const bf16_t* prow = proj + (size_t)(b * T_ + t_row) * NP;
    WaveSt S;
#pragma unroll
    for (int ds = 0; ds < 4; ++ds) S.qf[ds] = *(const bf16x8*)(prow + PC_MQ + mh * 64 + ds * 16 + hi * 8);
    ALAS float* wsf = (ALAS float*)(lds + L_WSF) + wave * 64;
    ALAS unsigned char* Kl = lds + L_K; ALAS unsigned char* Vl = lds + L_V;
    ALAS float* stg = (ALAS float*)(lds + L_STG) + wave * 2048;
    f32x16 p0, p1;
#pragma unroll
    for (int r = 0; r < 16; ++r) { S.o0[r] = 0.f; S.o1[r] = 0.f; }
    S.m = -1e30f; S.l = 0.f;
    const bf16_t* kp = mkv + (size_t)(b * NMEM) * 512 + mh * 64; const bf16_t* vp = kp + 256;
    TReg R;
    ld_k(R, kp, 512, wave, lane); ld_v(R, vp, 512, wave, lane);
    for (int jt = 0; jt < 4; ++jt) {
        st_k(R, Kl + par * 8192, tid); st_v(R, Vl + par * 8192, tid);
        if (jt + 1 < 4) { ld_k(R, kp + (size_t)(jt + 1) * 64 * 512, 512, wave, lane); ld_v(R, vp + (size_t)(jt + 1) * 64 * 512, 512, wave, lane); }
        wg_barrier();
        att_step<0, false>(Kl + par * 8192, Vl + par * 8192, S, wsf, lane, r32, hi, 0.f, 0, 0, 0u, true, 0.f, p0, p1);
        par ^= 1;
    }
    const float l_m = swap32_sum(S.l);
    fold<true>(S, stg, 1.f / l_m, wsf, r32, hi);
    store_rows(stg, lane, MemRowMap{proj, Y, b, mh, qb * 256 + 32 * wave});
}

__device__ __forceinline__ void conv_rows(const bf16_t* __restrict__ proj, const float* __restrict__ cw, const float* __restrict__ cb, bf16_t* __restrict__ Y, int r0, int nrows, int tid) {
    for (int item = tid; item < nrows * 32; item += 512) {
        const int m = r0 + (item >> 5), ch = item & 31, t = m & (T_ - 1), c0 = ch * 8;
        const bf16_t* p = proj + (size_t)m * NP;
        const u32x4 vb = *(const u32x4*)(p + PC_CB + c0), vg = *(const u32x4*)(p + PC_CG + c0);
        float acc[8];
#pragma unroll
        for (int j = 0; j < 8; ++j) acc[j] = cb[c0 + j];
#pragma unroll
        for (int k = 0; k < 3; ++k) {
            if (t - 2 + k >= 0) {
                const bf16_t* pp = p - (size_t)(2 - k) * NP;
                const u32x4 vc = *(const u32x4*)(pp + PC_CC + c0), vh = *(const u32x4*)(pp + PC_CH + c0);
                const unsigned cwv[4] = {vc.x, vc.y, vc.z, vc.w}, hwv[4] = {vh.x, vh.y, vh.z, vh.w};
#pragma unroll
                for (int j = 0; j < 4; ++j) {
                    acc[2 * j] += cw[k * 256 + c0 + 2 * j] * __uint_as_float(cwv[j] << 16) * __uint_as_float(hwv[j] << 16);
                    acc[2 * j + 1] += cw[k * 256 + c0 + 2 * j + 1] * __uint_as_float(cwv[j] & 0xffff0000u) * __uint_as_float(hwv[j] & 0xffff0000u);
                }
            }
        }
        const unsigned bw[4] = {vb.x, vb.y, vb.z, vb.w}, gw[4] = {vg.x, vg.y, vg.z, vg.w};
        unsigned ow[4];
#pragma unroll
        for (int j = 0; j < 4; ++j)
            ow[j] = cvtpk(__uint_as_float(bw[j] << 16) * acc[2 * j] * silu_f(__uint_as_float(gw[j] << 16)),
                          __uint_as_float(bw[j] & 0xffff0000u) * acc[2 * j + 1] * silu_f(__uint_as_float(gw[j] & 0xffff0000u)));
        *(u32x4*)(Y + (size_t)m * D_ + c0) = (u32x4){ow[0], ow[1], ow[2], ow[3]};
    }
}

__device__ __forceinline__ void att_phase(ALAS unsigned char* lds, const bf16_t* proj, const bf16_t* kvc, const bf16_t* mkv, const float* bgate, const float* cw, const float* cb, bf16_t* Y) {
    int par = 0;
    const int G = gridDim.x, tid = tid_opaque(), bid = bid_opaque();
    for (int u = bid; u < 1024; u += G) {
        const int bg = u & 7, s = (u >> 3) & 31, k = u >> 8;
        const int qb = k == 0 ? s : k == 1 ? 63 - s : k == 2 ? 64 + s : 127 - s;
        nsa_unit(lds, par, proj, kvc, bgate, Y, bg >> 1, bg & 1, qb, tid);
    }
    for (int u = bid; u < 512; u += G) mem_unit(lds, par, proj, mkv, Y, u >> 7, (u >> 5) & 3, u & 31, tid);
    for (int r0 = bid * 128; r0 < M_; r0 += G * 128) conv_rows(proj, cw, cb, Y, r0, 128, tid);
}
}

#define LAS __attribute__((address_space(3)))
#define XB_TMO      128
#define XB_XCNT(j)  (256  + 64 * (j))
#define XB_XSUB(j)  (1280 + 64 * (j))
#define XB_XGEN(j)  (2304 + 64 * (j))
#define XB_TOP      3328
#define XB_TOPGEN   3392
#define XCD_BAR_WORDS 3456
#define XB_SPIN_CAP (1u << 18)
__device__ __forceinline__ unsigned xb_ld(unsigned* p)              { return __hip_atomic_load(p, __ATOMIC_RELAXED, __HIP_MEMORY_SCOPE_AGENT); }
__device__ __forceinline__ unsigned xb_add(unsigned* p, unsigned v) { return __hip_atomic_fetch_add(p, v, __ATOMIC_RELAXED, __HIP_MEMORY_SCOPE_AGENT); }
__device__ __forceinline__ unsigned xb_xcc_id() { return (unsigned)__builtin_amdgcn_s_getreg((3 << 11) | 20) & 0xFu; }
#define XB_SPIN(cond, bar) do { unsigned _sp = 0; while (cond) { __builtin_amdgcn_s_sleep(1); \
    if ((++_sp & 255u) == 0u) { if (xb_ld(&(bar)[XB_TMO])) break; if (_sp > XB_SPIN_CAP) { atomicAdd(&(bar)[XB_TMO], 1u); break; } } } } while (0)
struct XcdBarrier { unsigned* bar; unsigned x; volatile LAS unsigned* st; };
__device__ __forceinline__ XcdBarrier xcd_barrier_post(unsigned* bar, volatile LAS unsigned* st) {
    XcdBarrier b; b.bar = bar; b.x = xb_xcc_id(); b.st = st;
    if (threadIdx.x == 0) (void)xb_add(&bar[XB_XCNT(b.x)], 1u);
    return b;
}
__device__ __forceinline__ void xcd_barrier_complete(unsigned* bar, unsigned x, unsigned& nloc, unsigned& nx) {
    const unsigned G = gridDim.x * gridDim.y * gridDim.z;
    unsigned sum, cnt, mine, sp = 0u;
    for (;;) {
        sum = 0u; cnt = 0u; mine = 0u;
#pragma unroll
        for (unsigned j = 0; j < 16; ++j) { const unsigned c = xb_ld(&bar[XB_XCNT(j)]); sum += c; cnt += (c > 0u) ? 1u : 0u; mine = (j == x) ? c : mine; }
        if (sum == G) break;
        __builtin_amdgcn_s_sleep(1);
        if ((++sp & 255u) == 0u) { if (xb_ld(&bar[XB_TMO])) break; if (sp > XB_SPIN_CAP) { atomicAdd(&bar[XB_TMO], 1u); break; } }
    }
    nloc = mine > 0u ? mine : 1u; nx = cnt > 0u ? cnt : 1u;
}
__device__ __forceinline__ void xcd_barrier(const XcdBarrier& b) {
    asm volatile("s_waitcnt vmcnt(0)" ::: "memory");
    __syncthreads();
    if (threadIdx.x == 0) {
        unsigned* bar = b.bar;
        __builtin_amdgcn_s_waitcnt(0);
        unsigned nloc = b.st[0], nx = b.st[1];
        if (nloc == 0u) { xcd_barrier_complete(bar, b.x, nloc, nx); b.st[0] = nloc; b.st[1] = nx; }
        const unsigned old = xb_add(&bar[XB_XSUB(b.x)], 1u);
        const unsigned gen = old / nloc;
        if (old + 1u == (gen + 1u) * nloc) {
            __builtin_amdgcn_fence(__ATOMIC_RELEASE, "agent");
            asm volatile("s_waitcnt vmcnt(0)" ::: "memory");
            const unsigned og = xb_add(&bar[XB_TOP], 1u);
            const unsigned tg = og / nx;
            if (og + 1u == (tg + 1u) * nx) xb_add(&bar[XB_TOPGEN], 1u);
            else XB_SPIN(xb_ld(&bar[XB_TOPGEN]) == tg, bar);
            __builtin_amdgcn_fence(__ATOMIC_ACQUIRE, "agent");
            xb_add(&bar[XB_XGEN(b.x)], 1u);
            asm volatile("s_waitcnt vmcnt(0)" ::: "memory");
        } else {
            XB_SPIN(xb_ld(&bar[XB_XGEN(b.x)]) == gen, bar);
            __builtin_amdgcn_fence(__ATOMIC_ACQUIRE, "agent");
            asm volatile("s_waitcnt vmcnt(0)" ::: "memory");
        }
    }
    __syncthreads();
}

constexpr int LDS_BYTES = 147456;
constexpr int RING_BYTES = 143360, MISC_OFF = RING_BYTES + 320;
static_assert(att::L_BYTES <= RING_BYTES && cmpf::L_BYTES <= RING_BYTES && pg8::STAGE_BYTES <= RING_BYTES, "LDS map");
constexpr int NPHASE = 1 + 5 * L_;
constexpr size_t WS_CTL = WS_END;
constexpr size_t CTL_BYTES = 65536;
constexpr size_t WS_TOTAL = WS_CTL + CTL_BYTES;

struct Args { const float* in[17]; float* out; unsigned char* ws; int ph_lo, ph_hi, use_bar, pad; };

__global__ void __launch_bounds__(512, 2) mega(Args a) {
    extern __shared__ __attribute__((aligned(16))) unsigned char lds_raw[];
    LAS unsigned char* lds = (LAS unsigned char*)lds_raw;
    const int G = gridDim.x;
    volatile LAS unsigned* MISC = (volatile LAS unsigned*)(lds + MISC_OFF);
    for (int u = threadIdx.x; u < (LDS_BYTES - RING_BYTES) / 4; u += 512) ((LAS unsigned*)(lds + RING_BYTES))[u] = 0u;
    __syncthreads();
    unsigned char* ws = a.ws;
    XcdBarrier bar; bar.bar = (unsigned*)(ws + WS_CTL) + 4096; bar.x = 0; bar.st = nullptr;
    if (a.use_bar) bar = xcd_barrier_post((unsigned*)(ws + WS_CTL) + 4096, MISC + 8);
#define P_IN(i) (a.in[i])
#define WSP(T, off) ((T*)(wsq + (off)))

    for (int ph = a.ph_lo; ph < a.ph_hi; ++ph) {
        unsigned char* wsq = a.ws; asm volatile("" : "+s"(wsq));
        if (ph == 0) {
            const int tid_ = tid_opaque(), lane = tid_ & 63, wave = __builtin_amdgcn_readfirstlane(tid_ >> 6), gw = bid_opaque() * 8 + wave, NGW = G * 8;
            LAS float* scr = (LAS float*)(lds + wave * 16384);
            constexpr int I_IN = 16 * (NP / 32), I_OUT = 16 * 32, I_MKV = 16 * 16, I_W1 = 32 * 8, I_W2 = 4 * 2;
            constexpr int PER_L = I_IN + I_OUT + I_MKV + 2 * I_W1 + 2 * I_W2;
            for (int it = gw; it < L_ * PER_L; it += NGW) {
                const int l = it / PER_L; int r = it % PER_L;
                if (r < I_IN) { misc::transpose_item<1>(P_IN(5) + (size_t)l * D_ * INW, INW, D_, NP, WSP(bf16_t, WS_WIN) + (size_t)l * NP * D_, scr, r, lane); continue; } r -= I_IN;
                if (r < I_OUT) { misc::transpose_item<0>(P_IN(16) + (size_t)l * D_ * D_, D_, D_, D_, WSP(bf16_t, WS_WOUT) + (size_t)l * D_ * D_, scr, r, lane); continue; } r -= I_OUT;
                if (r < I_MKV) { misc::transpose_item<0>(P_IN(15) + (size_t)l * D_ * 512, 512, D_, 512, WSP(bf16_t, WS_WMKV) + (size_t)l * 512 * D_, scr, r, lane); continue; } r -= I_MKV;
                if (r < 2 * I_W1) { const int kv = r / I_W1; misc::transpose_item<2>((kv ? P_IN(13) : P_IN(10)) + (size_t)l * 2048 * 256, 256, 2048, 256, WSP(bf16_t, WS_W1T) + (size_t)(l * 2 + kv) * 524288, scr, r % I_W1, lane); continue; } r -= 2 * I_W1;
                { const int kv = r / I_W2; misc::transpose_item<0>((kv ? P_IN(14) : P_IN(11)) + (size_t)l * 256 * 64, 64, 256, 64, WSP(bf16_t, WS_W2T) + (size_t)(l * 2 + kv) * 16384, scr, r % I_W2, lane); }
            }
            for (int it = gw; it < L_ * 2 * 4; it += NGW) {
                const int l = it >> 3, kv = (it >> 2) & 1, j = (it & 3) * 64 + lane;
                const float* pos = (kv ? P_IN(12) : P_IN(9)) + (size_t)l * 2048; const float* w1 = (kv ? P_IN(13) : P_IN(10)) + (size_t)l * 2048 * 256;
                float acc = 0.f;
                for (int k = 0; k < 2048; ++k) acc += pos[k] * w1[(size_t)k * 256 + j];
                WSP(float, WS_CB1)[(l * 2 + kv) * 256 + j] = acc;
            }
            for (int it = gw; it < L_ * B_ * NMEM; it += NGW) { const int l = it / (B_ * NMEM), r = it % (B_ * NMEM);
                misc::rms_row(P_IN(1) + (size_t)r * D_, P_IN(4) + (size_t)l * D_, WSP(bf16_t, WS_MEMN) + ((size_t)l * B_ * NMEM + r) * D_, lane); }
            for (int m = gw; m < M_; m += NGW) misc::rms_row(P_IN(0) + (size_t)m * D_, P_IN(2), WSP(bf16_t, WS_XN) + (size_t)m * D_, lane);
        } else {
            const int l = (ph - 1) / 5, sub = (ph - 1) % 5;
            if (sub == 0) {
#ifndef DIS_GEMM
#ifndef DIS_INP
                { pg8::Gemm g{WSP(bf16_t, WS_XN), WSP(bf16_t, WS_WIN) + (size_t)l * NP * D_, M_, NP, D_}; pg8::StaticOrder S; S.init(M_, NP, G, bid_opaque());
                  pg8::EpiProjF E{WSP(bf16_t, WS_PROJ), WSP(bf16_t, WS_CMPB)};
                  pg8::gemm_phase<pg8::EpiProjF, pg8::StaticOrder, true, true>(lds, g, S, E); }
#endif
#ifndef DIS_MKV
                if (l == 0) {
                    for (int ll = 0; ll < L_; ++ll) {
                        pg8::Gemm g{WSP(bf16_t, WS_MEMN) + (size_t)ll * B_ * NMEM * D_, WSP(bf16_t, WS_WMKV) + (size_t)ll * 512 * D_, B_ * NMEM, 512, D_}; pg8::StaticOrder S; S.init(B_ * NMEM, 512, G, (int)((bid_opaque() + G - 8 * ll) % G));
                        pg8::EpiMkvF E{WSP(bf16_t, WS_MKV) + (size_t)ll * B_ * NMEM * 512};
                        pg8::gemm_phase<pg8::EpiMkvF, pg8::StaticOrder, true, true>(lds, g, S, E);
                    }
                }
#endif
#endif
            } else if (sub == 1) {
#ifndef DIS_CMP
                cmpf::compress_phase(lds, WSP(bf16_t, WS_CMPB), WSP(bf16_t, WS_W1T) + (size_t)l * 2 * 524288, WSP(float, WS_CB1) + l * 512, WSP(bf16_t, WS_W2T) + (size_t)l * 2 * 16384, WSP(bf16_t, WS_KVC));
#endif
            } else if (sub == 2) {
#ifndef DIS_ATT
                att::att_phase(lds, WSP(bf16_t, WS_PROJ), WSP(bf16_t, WS_KVC), WSP(bf16_t, WS_MKV) + (size_t)l * B_ * NMEM * 512, P_IN(6) + l * 24, P_IN(7) + (size_t)l * 768, P_IN(8) + (size_t)l * 256, WSP(bf16_t, WS_Y));
#endif
            } else if (sub == 3) {
#if !defined(DIS_GEMM) && !defined(DIS_OUTP)
                pg8::Gemm g{WSP(bf16_t, WS_Y), WSP(bf16_t, WS_WOUT) + (size_t)l * D_ * D_, M_, D_, D_}; pg8::StaticOrder S; S.init(M_, D_, G, bid_opaque());
                pg8::EpiZF E{WSP(float, WS_PROJ)};
                pg8::gemm_phase<pg8::EpiZF, pg8::StaticOrder, true, true>(lds, g, S, E);
#endif
            } else {
                const int tid_ = tid_opaque(), lane = tid_ & 63, wave = __builtin_amdgcn_readfirstlane(tid_ >> 6), gw = bid_opaque() * 8 + wave, NGW = G * 8;
                const float* xin = l == 0 ? P_IN(0) : a.out;
                for (int m = gw; m < M_; m += NGW)
                    misc::resid_row(WSP(float, WS_PROJ) + (size_t)m * D_, xin + (size_t)m * D_, P_IN(3) + (size_t)l * D_, l + 1 < L_ ? P_IN(2) + (size_t)(l + 1) * D_ : nullptr, a.out + (size_t)m * D_, WSP(bf16_t, WS_XN) + (size_t)m * D_, lane);
            }
        }
        if (ph + 1 < a.ph_hi) { if (a.use_bar) { if (ph == 0) cooperative_groups::this_grid().sync(); else xcd_barrier(bar); } else __syncthreads(); }
        else { asm volatile("s_waitcnt vmcnt(0)" ::: "memory"); __syncthreads(); }
    }
}

#ifndef FAST_GEMM
#define FAST_GEMM 1
#endif
#ifndef FAST_CMP
#define FAST_CMP 1
#endif
#ifndef FAST_ATT
#define FAST_ATT 1
#endif
#ifndef ONE_LAUNCH
#define ONE_LAUNCH 1
#endif
static void launch_mega(const Args& base, int lo, int hi, int use_bar, int grid, hipStream_t stream) {
    Args a = base; a.ph_lo = lo; a.ph_hi = hi; a.use_bar = use_bar; a.pad = 0;
    if (use_bar) {
        void* params[] = {(void*)&a};
        hipError_t e = hipLaunchCooperativeKernel((const void*)mega, dim3(grid), dim3(512), params, LDS_BYTES, stream);
        if (e != hipSuccess) fprintf(stderr, "cooperative launch failed: %s (grid %d)\n", hipGetErrorString(e), grid);
    } else {
        hipLaunchKernelGGL(mega, dim3(grid), dim3(512), LDS_BYTES, stream, a);
    }
}
extern "C" void kernel_launch(void* const* d_in, const int* in_sizes, int n_in, void* d_out, int out_size, void* d_ws, size_t ws_size, hipStream_t stream) {
    static int grid = 0;
    if (grid == 0) {
        if (n_in != 17 || ws_size < WS_TOTAL || out_size != M_ * D_) { fprintf(stderr, "kernel_launch: bad args n_in %d ws %zu need %zu out %d\n", n_in, ws_size, (size_t)WS_TOTAL, out_size); grid = -1; return; }
        int dev = 0, cus = 0, per_cu = 0;
        if (hipGetDevice(&dev) != hipSuccess || hipDeviceGetAttribute(&cus, hipDeviceAttributeMultiprocessorCount, dev) != hipSuccess) { grid = -1; return; }
        if (hipFuncSetAttribute((const void*)mega, hipFuncAttributeMaxDynamicSharedMemorySize, LDS_BYTES) != hipSuccess) { fprintf(stderr, "hipFuncSetAttribute failed\n"); grid = -1; return; }
        if (hipOccupancyMaxActiveBlocksPerMultiprocessor(&per_cu, (const void*)mega, 512, LDS_BYTES) != hipSuccess || per_cu < 1) { fprintf(stderr, "occupancy query: %d\n", per_cu); per_cu = 1; }
        (void)hipGetLastError();
        grid = cus;
    }
    if (grid < 0) return;
    Args a{};
    for (int i = 0; i < 17; ++i) a.in[i] = (const float*)d_in[i];
    a.out = (float*)d_out; a.ws = (unsigned char*)d_ws;
    unsigned char* ws = (unsigned char*)d_ws; float* out = (float*)d_out;
    (void)hipMemsetAsync(ws + WS_CTL, 0, CTL_BYTES, stream);
#if ONE_LAUNCH
    launch_mega(a, 0, NPHASE, 1, grid, stream);
#else
    const float* x = (const float*)d_in[0];
    const float* pre_g = (const float*)d_in[2]; const float* post_g = (const float*)d_in[3];
    const float* b_gate = (const float*)d_in[6]; const float* conv_w = (const float*)d_in[7]; const float* conv_b = (const float*)d_in[8];
    const float* pos_k = (const float*)d_in[9]; const float* w1_k = (const float*)d_in[10]; const float* w2_k = (const float*)d_in[11];
    const float* pos_v = (const float*)d_in[12]; const float* w1_v = (const float*)d_in[13]; const float* w2_v = (const float*)d_in[14];
    bf16_t* Wt_in = (bf16_t*)(ws + WS_WIN); bf16_t* Wt_out = (bf16_t*)(ws + WS_WOUT);
    bf16_t* mkv = (bf16_t*)(ws + WS_MKV); bf16_t* XN = (bf16_t*)(ws + WS_XN);
    bf16_t* cmpb = (bf16_t*)(ws + WS_CMPB); bf16_t* kvc = (bf16_t*)(ws + WS_KVC); bf16_t* Y = (bf16_t*)(ws + WS_Y);
    bf16_t* proj = (bf16_t*)(ws + WS_PROJ); float* Z = (float*)(ws + WS_PROJ);
    launch_mega(a, 0, 1, 0, grid, stream);
    for (int l = 0; l < L_; ++l) {
        const int p0 = 1 + 5 * l;
#if FAST_GEMM
        launch_mega(a, p0, p0 + 1, 0, grid, stream);
#else
        k_gemm_naive<EpiProj><<<dim3(NP / 64, M_ / 64), 256, 0, stream>>>(XN, Wt_in + (size_t)l * NP * D_, D_, EpiProj{proj, cmpb});
        if (l == 0) for (int ll = 0; ll < L_; ++ll)
            k_gemm_naive<EpiMkv><<<dim3(512 / 64, B_ * NMEM / 64), 256, 0, stream>>>((bf16_t*)(ws + WS_MEMN) + (size_t)ll * B_ * NMEM * D_, (bf16_t*)(ws + WS_WMKV) + (size_t)ll * 512 * D_, D_, EpiMkv{mkv + (size_t)ll * B_ * NMEM * 512});
#endif
#if FAST_CMP
        launch_mega(a, p0 + 1, p0 + 2, 0, grid, stream);
#else
        k_compress_naive<<<2 * 8 * 512, 256, 0, stream>>>(cmpb, pos_k + (size_t)l * 2048, w1_k + (size_t)l * 2048 * 256, w2_k + (size_t)l * 256 * 64,
                                                          pos_v + (size_t)l * 2048, w1_v + (size_t)l * 2048 * 256, w2_v + (size_t)l * 256 * 64, kvc);
#endif
#if FAST_ATT
        launch_mega(a, p0 + 2, p0 + 3, 0, grid, stream);
#else
        k_nsa_naive<<<M_ * 2, 64, 0, stream>>>(proj, kvc, b_gate + l * 24, Y);
        k_mem_naive<<<M_ * 4, 64, 0, stream>>>(proj, mkv + (size_t)l * B_ * NMEM * 512, Y);
        k_conv<<<M_, 256, 0, stream>>>(proj, conv_w + (size_t)l * 3 * 256, conv_b + (size_t)l * 256, Y);
#endif
#if FAST_GEMM
        launch_mega(a, p0 + 3, p0 + 4, 0, grid, stream);
#else
        k_gemm_naive<EpiZ><<<dim3(D_ / 64, M_ / 64), 256, 0, stream>>>(Y, Wt_out + (size_t)l * D_ * D_, D_, EpiZ{Z});
#endif
        launch_mega(a, p0 + 4, p0 + 5, 0, grid, stream);
    }
#endif
}
```

```cpp
#include <hip/hip_cooperative_groups.h>

#include <hip/hip_runtime.h>
#include <cstdio>
#include <cstdint>
#include <cmath>

typedef unsigned short bf16_t;

constexpr int L_ = 4, B_ = 4, T_ = 8192, D_ = 1024, M_ = B_ * T_;
constexpr int INW = 3352;
constexpr int NP = 3584;
constexpr int NMEM = 256;
constexpr float EPS = 1e-6f;
constexpr float LOG2E = 1.4426950408889634f;
constexpr float C2 = 0.125f * LOG2E;

constexpr int PC_CB = 0, PC_CC = 256, PC_CH = 512, PC_CG = 768, PC_Q = 1024, PC_KC = 1536, PC_VC = 1664,
              PC_KS = 1792, PC_VS = 1920, PC_KW = 2048, PC_VW = 2176, PC_NG = 2304, PC_MQ = 2816, PC_MG = 3072, PC_GL = 3328;

constexpr size_t al256(size_t x) { return (x + 255) & ~(size_t)255; }
constexpr size_t WS_WIN = 0;
constexpr size_t WS_WOUT = WS_WIN + al256((size_t)L_ * NP * D_ * 2);
constexpr size_t WS_W1T = WS_WOUT + al256((size_t)L_ * D_ * D_ * 2);
constexpr size_t WS_W2T = WS_W1T + al256((size_t)L_ * 2 * 256 * 2048 * 2);
constexpr size_t WS_CB1 = WS_W2T + al256((size_t)L_ * 2 * 64 * 256 * 2);
constexpr size_t WS_WMKV = WS_CB1 + al256((size_t)L_ * 2 * 256 * 4);
constexpr size_t WS_MEMN = WS_WMKV + al256((size_t)L_ * 512 * D_ * 2);
constexpr size_t WS_MKV = WS_MEMN + al256((size_t)L_ * B_ * NMEM * D_ * 2);
constexpr size_t WS_XN = WS_MKV + al256((size_t)L_ * B_ * NMEM * 512 * 2);
constexpr size_t WS_CMPB = WS_XN + al256((size_t)M_ * D_ * 2);
constexpr size_t WS_KVC = WS_CMPB + al256((size_t)2 * B_ * 2 * T_ * 64 * 2 + 65536);
constexpr size_t WS_Y = WS_KVC + al256((size_t)2 * B_ * 2 * 512 * 64 * 2);
constexpr size_t WS_PROJ = WS_Y + al256((size_t)M_ * D_ * 2);
constexpr size_t WS_END = WS_PROJ + al256((size_t)M_ * NP * 2);

__device__ __forceinline__ float bf2f(bf16_t v) { return __uint_as_float((unsigned)v << 16); }
__device__ __forceinline__ bf16_t f2bf(float f) { unsigned u = __float_as_uint(f); return (bf16_t)((u + 0x7fffu + ((u >> 16) & 1u)) >> 16); }
__device__ __forceinline__ float wave_sum(float v) {
#pragma unroll
    for (int o = 1; o < 64; o <<= 1) v += __shfl_xor(v, o);
    return v;
}
__device__ __forceinline__ float wave_max(float v) {
#pragma unroll
    for (int o = 1; o < 64; o <<= 1) v = fmaxf(v, __shfl_xor(v, o));
    return v;
}
__device__ __forceinline__ float silu_f(float x) { return x / (1.f + __expf(-x)); }
__device__ __forceinline__ float sigmoid_f(float x) { return 1.f / (1.f + __expf(-x)); }
__device__ __forceinline__ float gelu_tanh(float x) {
    const float u = 0.7978845608028654f * (x + 0.044715f * x * x * x);
    return 0.5f * x * (1.f + tanhf(u));
}
__host__ __device__ __forceinline__ int orig_col(int pc) {
    if (pc < 2304) return pc;
    if (pc < 3328) return pc + 24;
    if (pc < 3352) return pc - 3328 + 2304;
    return -1;
}

__global__ __launch_bounds__(256) void k_transpose(const float* __restrict__ src, int ldsrc, int K, int N, bf16_t* __restrict__ dst, int mode) {
    __shared__ float tile[64][65];
    const int n0 = blockIdx.x * 64, k0 = blockIdx.y * 64, tid = threadIdx.x;
    for (int i = 0; i < 16; ++i) {
        const int kk = i * 4 + (tid >> 6), nn = tid & 63, n = n0 + nn;
        float v = 0.f;
        if (mode == 1) { const int oc = orig_col(n); if (oc >= 0) { v = src[(size_t)(k0 + kk) * ldsrc + oc]; if ((n >= PC_Q && n < PC_Q + 512) || (n >= PC_MQ && n < PC_MQ + 256)) v *= C2; } }
        else v = src[(size_t)(k0 + kk) * ldsrc + n];
        tile[kk][nn] = v;
    }
    __syncthreads();
    for (int i = 0; i < 16; ++i) {
        const int nn = i * 4 + (tid >> 6), kk = tid & 63;
        dst[(size_t)(n0 + nn) * K + k0 + kk] = f2bf(tile[kk][nn]);
    }
}
__global__ __launch_bounds__(256) void k_cmp_bias(const float* __restrict__ pos, const float* __restrict__ w1, float* __restrict__ out) {
    const int j = threadIdx.x; float acc = 0.f;
    for (int k = 0; k < 2048; ++k) acc += pos[k] * w1[(size_t)k * 256 + j];
    out[j] = acc;
}
__global__ __launch_bounds__(256) void k_rmsnorm_rows(const float* __restrict__ x, const float* __restrict__ g, bf16_t* __restrict__ out, int nrows) {
    const int row = blockIdx.x * 4 + (threadIdx.x >> 6), lane = threadIdx.x & 63;
    if (row >= nrows) return;
    const float4* xr = (const float4*)(x + (size_t)row * D_);
    float4 v[4]; float s = 0.f;
#pragma unroll
    for (int j = 0; j < 4; ++j) { v[j] = xr[lane + 64 * j]; s += v[j].x * v[j].x + v[j].y * v[j].y + v[j].z * v[j].z + v[j].w * v[j].w; }
    const float r = rsqrtf(wave_sum(s) * (1.f / D_) + EPS);
#pragma unroll
    for (int j = 0; j < 4; ++j) {
        const float4 gg = ((const float4*)g)[lane + 64 * j];
        bf16_t* o = out + (size_t)row * D_ + (lane + 64 * j) * 4;
        o[0] = f2bf(v[j].x * r * gg.x); o[1] = f2bf(v[j].y * r * gg.y); o[2] = f2bf(v[j].z * r * gg.z); o[3] = f2bf(v[j].w * r * gg.w);
    }
}

struct EpiProj { bf16_t* proj; bf16_t* cmpb; };
struct EpiZ { float* z; };
struct EpiMkv { bf16_t* o; };
__device__ __forceinline__ void epi_store(const EpiProj& e, int row, int col, float v) {
    e.proj[(size_t)row * NP + col] = f2bf(v);
    if (col >= PC_KC && col < PC_KC + 256) {
        const int c = col - PC_KC, kv = c >> 7, g = (c >> 6) & 1, d = c & 63, b = row / T_, t = row % T_;
        e.cmpb[((size_t)((kv * B_ + b) * 2 + g) * T_ + t) * 64 + d] = f2bf(v);
    }
}
__device__ __forceinline__ void epi_store(const EpiZ& e, int row, int col, float v) { e.z[(size_t)row * D_ + col] = v; }
__device__ __forceinline__ void epi_store(const EpiMkv& e, int row, int col, float v) { e.o[(size_t)row * 512 + col] = f2bf(v); }

template <class Epi>
__global__ __launch_bounds__(256) void k_gemm_naive(const bf16_t* __restrict__ A, const bf16_t* __restrict__ Bt, int K, Epi e) {
    __shared__ float As[32][68];
    __shared__ float Bs[32][68];
    const int tid = threadIdx.x, tx = tid & 15, ty = tid >> 4;
    const int m0 = blockIdx.y * 64, n0 = blockIdx.x * 64;
    float acc[4][4] = {};
    const int lr = tid >> 2, lk = (tid & 3) * 8;
    for (int k0 = 0; k0 < K; k0 += 32) {
        const uint4 av = *(const uint4*)(A + (size_t)(m0 + lr) * K + k0 + lk);
        const uint4 bv = *(const uint4*)(Bt + (size_t)(n0 + lr) * K + k0 + lk);
        const unsigned aw[4] = {av.x, av.y, av.z, av.w}, bw[4] = {bv.x, bv.y, bv.z, bv.w};
#pragma unroll
        for (int i = 0; i < 4; ++i) {
            As[lk + 2 * i][lr] = __uint_as_float(aw[i] << 16); As[lk + 2 * i + 1][lr] = __uint_as_float(aw[i] & 0xffff0000u);
            Bs[lk + 2 * i][lr] = __uint_as_float(bw[i] << 16); Bs[lk + 2 * i + 1][lr] = __uint_as_float(bw[i] & 0xffff0000u);
        }
        __syncthreads();
#pragma unroll
        for (int k = 0; k < 32; ++k) {
            const float4 a = *(const float4*)&As[k][ty * 4];
            const float4 b = *(const float4*)&Bs[k][tx * 4];
            const float aa[4] = {a.x, a.y, a.z, a.w}, bb[4] = {b.x, b.y, b.z, b.w};
#pragma unroll
            for (int i = 0; i < 4; ++i)
#pragma unroll
                for (int j = 0; j < 4; ++j) acc[i][j] += aa[i] * bb[j];
        }
        __syncthreads();
    }
#pragma unroll
    for (int i = 0; i < 4; ++i)
#pragma unroll
        for (int j = 0; j < 4; ++j) epi_store(e, m0 + ty * 4 + i, n0 + tx * 4 + j, acc[i][j]);
}

__global__ __launch_bounds__(256) void k_compress_naive(const bf16_t* __restrict__ cmpb, const float* __restrict__ pos_k, const float* __restrict__ w1_k, const float* __restrict__ w2_k,
                                                        const float* __restrict__ pos_v, const float* __restrict__ w1_v, const float* __restrict__ w2_v, bf16_t* __restrict__ kvc) {
    __shared__ float flat[2048];
    __shared__ float hid[256];
    const int i = blockIdx.x & 511, bg = (blockIdx.x >> 9) & 7, kv = blockIdx.x >> 12, tid = threadIdx.x;
    bf16_t* out = kvc + ((size_t)(kv * 8 + bg) * 512 + i) * 64;
    if (i == 511) { if (tid < 64) out[tid] = 0; return; }
    const float* pos = kv ? pos_v : pos_k; const float* w1 = kv ? w1_v : w1_k; const float* w2 = kv ? w2_v : w2_k;
    const bf16_t* src = cmpb + ((size_t)(kv * 8 + bg) * T_ + 16 * i) * 64;
    for (int k = tid; k < 2048; k += 256) flat[k] = bf2f(src[k]) + pos[k];
    __syncthreads();
    float acc = 0.f;
    for (int k = 0; k < 2048; ++k) acc += flat[k] * w1[(size_t)k * 256 + tid];
    hid[tid] = gelu_tanh(acc);
    __syncthreads();
    if (tid < 64) { float o = 0.f; for (int j = 0; j < 256; ++j) o += hid[j] * w2[j * 64 + tid]; out[tid] = f2bf(o); }
}

__device__ __forceinline__ float slope2_of(int hd) { return exp2f(-(float)(hd + 1)) * LOG2E; }
__device__ __forceinline__ void dot4(const float (*q)[64], const bf16_t* row, float& d0, float& d1, float& d2, float& d3) {
    d0 = d1 = d2 = d3 = 0.f;
#pragma unroll 1
    for (int c = 0; c < 8; ++c) {
        const uint4 v = ((const uint4*)row)[c];
        const unsigned w[4] = {v.x, v.y, v.z, v.w};
#pragma unroll
        for (int i = 0; i < 4; ++i) {
            const float lo = __uint_as_float(w[i] << 16), hi = __uint_as_float(w[i] & 0xffff0000u);
            const int d = c * 8 + 2 * i;
            d0 += q[0][d] * lo + q[0][d + 1] * hi; d1 += q[1][d] * lo + q[1][d + 1] * hi;
            d2 += q[2][d] * lo + q[2][d + 1] * hi; d3 += q[3][d] * lo + q[3][d + 1] * hi;
        }
    }
}
__device__ __forceinline__ void softmax4(float (*sc)[1024], int n, int lane) {
    for (int h = 0; h < 4; ++h) {
        float mx = -INFINITY;
        for (int j = lane; j < n; j += 64) mx = fmaxf(mx, sc[h][j]);
        mx = wave_max(mx);
        if (!(mx > -INFINITY)) mx = 0.f;
        float sum = 0.f;
        for (int j = lane; j < n; j += 64) { const float p = exp2f(sc[h][j] - mx); sc[h][j] = p; sum += p; }
        sum = wave_sum(sum);
        const float inv = 1.f / fmaxf(sum, 1e-30f);
        for (int j = lane; j < n; j += 64) sc[h][j] *= inv;
    }
}
__global__ __launch_bounds__(64) void k_nsa_naive(const bf16_t* __restrict__ proj, const bf16_t* __restrict__ kvc, const float* __restrict__ b_gate, bf16_t* __restrict__ Y) {
    __shared__ float s_q[4][64];
    __shared__ float s_sc[4][1024];
    __shared__ float s_imp[512];
    __shared__ float s_isel[128];
    __shared__ float s_o[3][4][64];
    __shared__ int s_blk[16];
    const int lane = threadIdx.x;
    const int g = blockIdx.x & 1, m = blockIdx.x >> 1, b = m / T_, t = m % T_;
    const bf16_t* prow = proj + (size_t)m * NP;
    for (int h = 0; h < 4; ++h) s_q[h][lane] = bf2f(prow[PC_Q + (g * 4 + h) * 64 + lane]);
    __syncthreads();
    const float sl0 = slope2_of(g * 4 + 0), sl1 = slope2_of(g * 4 + 1), sl2 = slope2_of(g * 4 + 2), sl3 = slope2_of(g * 4 + 3);
    const int nv = t >= 31 ? min((t - 31) / 16 + 1, 511) : 0;
    const bf16_t* kc = kvc + (size_t)((0 * B_ + b) * 2 + g) * 512 * 64;
    const bf16_t* vc = kvc + (size_t)((1 * B_ + b) * 2 + g) * 512 * 64;
    for (int i = lane; i < nv; i += 64) {
        float d0, d1, d2, d3; dot4(s_q, kc + i * 64, d0, d1, d2, d3);
        const float dist = (float)(t - (16 * i + 31));
        s_sc[0][i] = d0 - sl0 * dist; s_sc[1][i] = d1 - sl1 * dist; s_sc[2][i] = d2 - sl2 * dist; s_sc[3][i] = d3 - sl3 * dist;
    }
    __syncthreads();
    softmax4(s_sc, nv, lane);
    __syncthreads();
    {
        float o0 = 0.f, o1 = 0.f, o2 = 0.f, o3 = 0.f;
        for (int i = 0; i < nv; ++i) { const float v = bf2f(vc[i * 64 + lane]); o0 += s_sc[0][i] * v; o1 += s_sc[1][i] * v; o2 += s_sc[2][i] * v; o3 += s_sc[3][i] * v; }
        s_o[0][0][lane] = o0; s_o[0][1][lane] = o1; s_o[0][2][lane] = o2; s_o[0][3][lane] = o3;
    }
    for (int i = lane; i < 512; i += 64) s_imp[i] = i < nv ? (s_sc[0][i] + s_sc[1][i] + s_sc[2][i] + s_sc[3][i]) : 0.f;
    __syncthreads();
    const int cur = t >> 6;
    for (int blk = lane; blk < 128; blk += 64) {
        float v = (blk > 0 ? s_imp[4 * blk - 1] : 0.f) + 2.f * (s_imp[4 * blk] + s_imp[4 * blk + 1] + s_imp[4 * blk + 2]) + s_imp[4 * blk + 3];
        if (blk == 0 || blk == cur || blk == cur - 1) v = 1e4f; else if (blk > cur) v = -1.f;
        s_isel[blk] = v;
    }
    __syncthreads();
    bool sel0, sel1;
    {
        const float v0 = s_isel[lane], v1 = s_isel[lane + 64]; int r0 = 0, r1 = 0;
        for (int o = 0; o < 128; ++o) { const float vo = s_isel[o]; r0 += (vo > v0 || (vo == v0 && o < lane)) ? 1 : 0; r1 += (vo > v1 || (vo == v1 && o < lane + 64)) ? 1 : 0; }
        sel0 = r0 < 16 && lane <= cur; sel1 = r1 < 16 && lane + 64 <= cur;
    }
    const unsigned long long m0 = __ballot(sel0), m1 = __ballot(sel1);
    int nsel = 0;
    {
        unsigned long long mm = m0; int base = 0;
        for (int pass = 0; pass < 2; ++pass) {
            while (mm) { const int bit = __ffsll((long long)mm) - 1; mm &= mm - 1; if (lane == 0) s_blk[nsel] = base + bit; ++nsel; }
            mm = m1; base = 64;
        }
    }
    __syncthreads();
    for (int k = 0; k < nsel; ++k) {
        const int pos = s_blk[k] * 64 + lane;
        float d0, d1, d2, d3; dot4(s_q, proj + (size_t)(b * T_ + pos) * NP + PC_KS + g * 64, d0, d1, d2, d3);
        const float dist = (float)(t - pos); const bool ok = pos <= t;
        s_sc[0][k * 64 + lane] = ok ? d0 - sl0 * dist : -INFINITY; s_sc[1][k * 64 + lane] = ok ? d1 - sl1 * dist : -INFINITY;
        s_sc[2][k * 64 + lane] = ok ? d2 - sl2 * dist : -INFINITY; s_sc[3][k * 64 + lane] = ok ? d3 - sl3 * dist : -INFINITY;
    }
    __syncthreads();
    softmax4(s_sc, nsel * 64, lane);
    __syncthreads();
    {
        float o0 = 0.f, o1 = 0.f, o2 = 0.f, o3 = 0.f;
        for (int k = 0; k < nsel; ++k) {
            const bf16_t* vr = proj + (size_t)(b * T_ + s_blk[k] * 64) * NP + PC_VS + g * 64 + lane;
            for (int j = 0; j < 64; ++j) { const float v = bf2f(vr[(size_t)j * NP]); const int jj = k * 64 + j; o0 += s_sc[0][jj] * v; o1 += s_sc[1][jj] * v; o2 += s_sc[2][jj] * v; o3 += s_sc[3][jj] * v; }
        }
        s_o[1][0][lane] = o0; s_o[1][1][lane] = o1; s_o[1][2][lane] = o2; s_o[1][3][lane] = o3;
    }
    __syncthreads();
    for (int jj = 0; jj < 8; ++jj) {
        const int j = jj * 64 + lane, pos = t - 511 + j;
        if (pos >= 0) {
            float d0, d1, d2, d3; dot4(s_q, proj + (size_t)(b * T_ + pos) * NP + PC_KW + g * 64, d0, d1, d2, d3);
            const float dist = (float)(t - pos);
            s_sc[0][j] = d0 - sl0 * dist; s_sc[1][j] = d1 - sl1 * dist; s_sc[2][j] = d2 - sl2 * dist; s_sc[3][j] = d3 - sl3 * dist;
        } else { s_sc[0][j] = -INFINITY; s_sc[1][j] = -INFINITY; s_sc[2][j] = -INFINITY; s_sc[3][j] = -INFINITY; }
    }
    __syncthreads();
    softmax4(s_sc, 512, lane);
    __syncthreads();
    {
        float o0 = 0.f, o1 = 0.f, o2 = 0.f, o3 = 0.f;
        const int j0 = t >= 511 ? 0 : 511 - t;
        for (int j = j0; j < 512; ++j) { const float v = bf2f(proj[(size_t)(b * T_ + t - 511 + j) * NP + PC_VW + g * 64 + lane]); o0 += s_sc[0][j] * v; o1 += s_sc[1][j] * v; o2 += s_sc[2][j] * v; o3 += s_sc[3][j] * v; }
        s_o[2][0][lane] = o0; s_o[2][1][lane] = o1; s_o[2][2][lane] = o2; s_o[2][3][lane] = o3;
    }
    __syncthreads();
    for (int h = 0; h < 4; ++h) {
        const int hd = g * 4 + h;
        const float g0 = sigmoid_f(bf2f(prow[PC_GL + 0 * 8 + hd]) + b_gate[0 * 8 + hd]);
        const float g1 = sigmoid_f(bf2f(prow[PC_GL + 1 * 8 + hd]) + b_gate[1 * 8 + hd]);
        const float g2 = sigmoid_f(bf2f(prow[PC_GL + 2 * 8 + hd]) + b_gate[2 * 8 + hd]);
        const float o = g0 * s_o[0][h][lane] + g1 * s_o[1][h][lane] + g2 * s_o[2][h][lane];
        const float ng = bf2f(prow[PC_NG + hd * 64 + lane]);
        Y[(size_t)m * D_ + 256 + hd * 64 + lane] = f2bf(o * silu_f(ng));
    }
}

__global__ __launch_bounds__(64) void k_mem_naive(const bf16_t* __restrict__ proj, const bf16_t* __restrict__ mkv, bf16_t* __restrict__ Y) {
    __shared__ float s_q[64];
    __shared__ float s_p[256];
    const int lane = threadIdx.x, hd = blockIdx.x & 3, m = blockIdx.x >> 2, b = m / T_;
    const bf16_t* prow = proj + (size_t)m * NP;
    s_q[lane] = bf2f(prow[PC_MQ + hd * 64 + lane]);
    __syncthreads();
    const bf16_t* kb = mkv + (size_t)(b * NMEM) * 512 + hd * 64;
    float sc[4], mx = -INFINITY;
#pragma unroll
    for (int u = 0; u < 4; ++u) {
        const int key = u * 64 + lane; float dot = 0.f;
        for (int d = 0; d < 64; ++d) dot += s_q[d] * bf2f(kb[(size_t)key * 512 + d]);
        sc[u] = dot; mx = fmaxf(mx, dot);
    }
    mx = wave_max(mx);
    float sum = 0.f;
#pragma unroll
    for (int u = 0; u < 4; ++u) { sc[u] = exp2f(sc[u] - mx); sum += sc[u]; s_p[u * 64 + lane] = sc[u]; }
    sum = wave_sum(sum);
    __syncthreads();
    float o = 0.f;
    for (int key = 0; key < 256; ++key) o += s_p[key] * bf2f(kb[(size_t)key * 512 + 256 + lane]);
    o /= sum;
    Y[(size_t)m * D_ + 768 + hd * 64 + lane] = f2bf(o * silu_f(bf2f(prow[PC_MG + hd * 64 + lane])));
}

__global__ __launch_bounds__(256) void k_conv(const bf16_t* __restrict__ proj, const float* __restrict__ cw, const float* __restrict__ cb, bf16_t* __restrict__ Y) {
    const int m = blockIdx.x, c = threadIdx.x, t = m % T_;
    const bf16_t* p = proj + (size_t)m * NP;
    float acc = cb[c];
#pragma unroll
    for (int k = 0; k < 3; ++k) {
        const int tt = t - 2 + k;
        if (tt >= 0) { const bf16_t* pp = p - (size_t)(2 - k) * NP; acc += cw[k * 256 + c] * bf2f(pp[PC_CC + c]) * bf2f(pp[PC_CH + c]); }
    }
    Y[(size_t)m * D_ + c] = f2bf(bf2f(p[PC_CB + c]) * acc * silu_f(bf2f(p[PC_CG + c])));
}

__global__ __launch_bounds__(256) void k_resid(const float* __restrict__ z, const float* xin, const float* __restrict__ gpost, const float* __restrict__ gpre_next, float* xout, bf16_t* __restrict__ xn) {
    const int row = blockIdx.x * 4 + (threadIdx.x >> 6), lane = threadIdx.x & 63;
    const float4* zr = (const float4*)(z + (size_t)row * D_);
    const float4* xr = (const float4*)(xin + (size_t)row * D_);
    float4 v[4]; float s = 0.f;
#pragma unroll
    for (int j = 0; j < 4; ++j) { v[j] = zr[lane + 64 * j]; s += v[j].x * v[j].x + v[j].y * v[j].y + v[j].z * v[j].z + v[j].w * v[j].w; }
    const float r = rsqrtf(wave_sum(s) * (1.f / D_) + EPS);
    float s2 = 0.f;
#pragma unroll
    for (int j = 0; j < 4; ++j) {
        const float4 gg = ((const float4*)gpost)[lane + 64 * j]; const float4 xx = xr[lane + 64 * j];
        v[j].x = xx.x + v[j].x * r * gg.x; v[j].y = xx.y + v[j].y * r * gg.y; v[j].z = xx.z + v[j].z * r * gg.z; v[j].w = xx.w + v[j].w * r * gg.w;
        s2 += v[j].x * v[j].x + v[j].y * v[j].y + v[j].z * v[j].z + v[j].w * v[j].w;
        ((float4*)(xout + (size_t)row * D_))[lane + 64 * j] = v[j];
    }
    if (gpre_next) {
        const float r2 = rsqrtf(wave_sum(s2) * (1.f / D_) + EPS);
#pragma unroll
        for (int j = 0; j < 4; ++j) {
            const float4 gg = ((const float4*)gpre_next)[lane + 64 * j];
            bf16_t* o = xn + (size_t)row * D_ + (lane + 64 * j) * 4;
            o[0] = f2bf(v[j].x * r2 * gg.x); o[1] = f2bf(v[j].y * r2 * gg.y); o[2] = f2bf(v[j].z * r2 * gg.z); o[3] = f2bf(v[j].w * r2 * gg.w);
        }
    }
}


__device__ __forceinline__ int tid_opaque() { int t = threadIdx.x; asm volatile("" : "+v"(t)); return t; }
__device__ __forceinline__ int bid_opaque() { int t = blockIdx.x; asm volatile("" : "+s"(t)); return t; }

namespace pg8 {
#define PG8_LAS __attribute__((address_space(3)))
typedef unsigned short bf16_t;
typedef short bf16x8 __attribute__((ext_vector_type(8)));
typedef float f32x4 __attribute__((ext_vector_type(4)));
typedef unsigned u32x4 __attribute__((ext_vector_type(4)));
constexpr int BM = 256, BK = 64, HALF = 128, HTB = HALF * BK * 2  , STAGE_BYTES = 8 * HTB, NXCD = 8, WGM = 8;

__host__ __device__ __forceinline__ int lds_byte(int r, int c) { const int st = (r >> 4) * 2 + (c >> 5), rr = r & 15, cc = c & 31, ob = rr * 64 + cc * 2; return st * 1024 + (ob ^ (((ob >> 9) & 1) << 5)); }
__host__ __device__ __forceinline__ void stage_rc(int b, int& R, int& C) { const int st = b / 1024, sb = b % 1024, swz = sb ^ (((sb >> 9) & 1) << 5); R = (st >> 1) * 16 + swz / 64; C = (st & 1) * 32 + (swz % 64) / 2; }
__host__ __device__ __forceinline__ int perm32(int rho) { const int n = rho >> 4, i = rho & 15; return 8 * (i >> 2) + 4 * n + (i & 3); }

struct Unit { int pm, pn; };
struct Gemm { const bf16_t* A; const bf16_t* Bt; int M, N, K; };

struct StaticOrder {
    int nM, nN, nwg, G, c;
    __host__ __device__ void init(int M, int N, int G_, int c_) { nM = M / BM; nN = N / BM; nwg = nM * nN; G = G_; c = c_; }
    __host__ __device__ bool next(int i, Unit& u) const {
        const long L = (long)i * G + c; if (L >= nwg) return false;
        int wgid = (int)L; { const int q = nwg / NXCD, r = nwg % NXCD, xcd = wgid % NXCD, off = wgid / NXCD; wgid = (xcd < r ? xcd * (q + 1) : r * (q + 1) + (xcd - r) * q) + off; }
        const int nig = WGM * nN, gid = wgid / nig, fm = gid * WGM, gsz = (nM - fm) < WGM ? (nM - fm) : WGM;
        u.pm = fm + ((wgid % nig) % gsz); u.pn = (wgid % nig) / gsz; return true;
    }
    __device__ __forceinline__ void a_ready(const Unit&) const {}
    __device__ __forceinline__ void done(const Unit&) const {}
};


__device__ __forceinline__ unsigned cvt_pk_bf16(float lo, float hi) { unsigned r; asm volatile("v_cvt_pk_bf16_f32 %0, %1, %2" : "=v"(r) : "v"(lo), "v"(hi)); return r; }

template <class Epi, class Sched, bool ALIGN_EPI = false, bool SP2 = false>
__device__ __forceinline__ void gemm_phase(PG8_LAS unsigned char* lds, const Gemm g, const Sched& S, const Epi& E) {
    const int tid = tid_opaque(), wid = __builtin_amdgcn_readfirstlane(tid >> 6), lane = tid & 63, wr = wid >> 2, wc = wid & 3, fr = lane & 15, fq = lane >> 4;
    const int K = g.K, nt = K / BK;
    unsigned voffA[2], voffB[2];
#pragma unroll
    for (int i = 0; i < 2; ++i) { int R, C; stage_rc(tid * 16 + i * 8192, R, C); const int Rb = Epi::PERM ? ((R & ~31) + perm32(R & 31)) : R;
        voffA[i] = (unsigned)(R * K + C) * 2u; voffB[i] = (unsigned)(Rb * K + C) * 2u; }
    const size_t kstep = (size_t)(BK * 2);
    const size_t hstep = (size_t)HALF * K * 2;
    const size_t tstep = 2 * hstep;
    const unsigned ldsw = (unsigned)wid * 1024u;
    const int aoff = lds_byte(wr * 64 + fr, fq * 8), boff = lds_byte(wc * 32 + fr, fq * 8);
#define PG8_SA(b, h) (((b) * 2 + (h)) * HTB)
#define PG8_SB(b, h) ((4 + (b) * 2 + (h)) * HTB)
#define PG8_STAGE(bufoff, gbase, voff) do { _Pragma("unroll") for (int _i = 0; _i < 2; ++_i) \
        __builtin_amdgcn_global_load_lds((const unsigned*)((const char*)(gbase) + (voff)[_i]), (PG8_LAS unsigned*)(lds + (bufoff) + ldsw + _i * 8192), 16, 0, 0); } while (0)
#define PG8_LDA(dst, b, h) do { _Pragma("unroll") for (int m = 0; m < 4; ++m) _Pragma("unroll") for (int k = 0; k < 2; ++k) dst[m][k] = *(const PG8_LAS bf16x8*)(lds + PG8_SA(b, h) + aoff + m * 2048 + k * 1024); } while (0)
#define PG8_LDB(dst, b, h) do { _Pragma("unroll") for (int n = 0; n < 2; ++n) _Pragma("unroll") for (int k = 0; k < 2; ++k) dst[n][k] = *(const PG8_LAS bf16x8*)(lds + PG8_SB(b, h) + boff + n * 2048 + k * 1024); } while (0)
#define PG8_MMA(ai, bj, At, Bt) do { __builtin_amdgcn_s_setprio(1); _Pragma("unroll") for (int m = 0; m < 4; ++m) _Pragma("unroll") for (int n = 0; n < 2; ++n) _Pragma("unroll") for (int k = 0; k < 2; ++k) \
        acc[ai][bj][m][n] = __builtin_amdgcn_mfma_f32_16x16x32_bf16(Bt[n][k], At[m][k], acc[ai][bj][m][n], 0, 0, 0); __builtin_amdgcn_s_setprio(0); } while (0)
#define PG8_WAIT_V(n) asm volatile("s_waitcnt vmcnt(" #n ")" ::: "memory")
#define PG8_WAIT_L(n) asm volatile("s_waitcnt lgkmcnt(" #n ")" ::: "memory")
#define PG8_BAR __builtin_amdgcn_s_barrier()
#define PG8_SCHED __builtin_amdgcn_sched_barrier(0)
    Unit cur, nxt; int ui = 0;
    if (!S.next(0, cur)) return;
    f32x4 acc[2][2][4][2];
#pragma unroll
    for (int a = 0; a < 2; ++a)
#pragma unroll
        for (int b = 0; b < 2; ++b)
#pragma unroll
            for (int m = 0; m < 4; ++m)
#pragma unroll
                for (int n = 0; n < 2; ++n) acc[a][b][m][n] = (f32x4){0.f, 0.f, 0.f, 0.f};
    bf16x8 At[4][2], B0[2][2], B1[2][2];
    const char* cA = (const char*)g.A + (size_t)cur.pm * tstep; const char* cB = (const char*)g.Bt + (size_t)cur.pn * tstep;
    S.a_ready(cur);
    if constexpr (SP2) {
        PG8_STAGE(PG8_SB(0, 0), cB, voffB); PG8_STAGE(PG8_SB(0, 1), cB + hstep, voffB); PG8_STAGE(PG8_SA(0, 0), cA, voffA); PG8_STAGE(PG8_SA(0, 1), cA + hstep, voffA);
        if (wr == 1) PG8_BAR;
        PG8_WAIT_V(2); PG8_BAR;
        PG8_STAGE(PG8_SB(1, 0), cB + kstep, voffB); PG8_STAGE(PG8_SA(1, 0), cA + kstep, voffA); PG8_STAGE(PG8_SB(1, 1), cB + hstep + kstep, voffB);
        PG8_WAIT_V(6); PG8_BAR;
    } else {
        PG8_STAGE(PG8_SB(0, 0), cB, voffB); PG8_STAGE(PG8_SA(0, 0), cA, voffA); PG8_STAGE(PG8_SB(0, 1), cB + hstep, voffB); PG8_STAGE(PG8_SA(0, 1), cA + hstep, voffA);
        if (wr == 1) PG8_BAR;
        PG8_WAIT_V(4); PG8_BAR;
        PG8_STAGE(PG8_SB(1, 0), cB + kstep, voffB); PG8_STAGE(PG8_SA(1, 0), cA + kstep, voffA); PG8_STAGE(PG8_SB(1, 1), cB + hstep + kstep, voffB);
        PG8_WAIT_V(6); PG8_BAR;
    }
    for (;;) {
        const bool has_next = S.next(ui + 1, nxt);
        const char* nA = has_next ? (const char*)g.A + (size_t)nxt.pm * tstep : cA; const char* nB = has_next ? (const char*)g.Bt + (size_t)nxt.pn * tstep : cB;
        for (int t = 0; t < nt; t += 2) {
            const bool last = (t == nt - 2);
            const char* a1 = cA + (size_t)(t + 1) * kstep;
            const char* a2 = last ? nA : cA + (size_t)(t + 2) * kstep; const char* b2 = last ? nB : cB + (size_t)(t + 2) * kstep;
            const char* a3 = a2 + kstep; const char* b3 = b2 + kstep;
            if (last && has_next) S.a_ready(nxt);
            if constexpr (SP2) {
            PG8_LDB(B0, 0, 0); PG8_LDB(B1, 0, 1); PG8_SCHED; PG8_LDA(At, 0, 0); PG8_STAGE(PG8_SA(1, 1), a1 + hstep, voffA);
            PG8_WAIT_V(8); PG8_WAIT_L(0); PG8_BAR; PG8_MMA(0, 0, At, B0); PG8_MMA(0, 1, At, B1); PG8_BAR; PG8_SCHED;
            PG8_LDA(At, 0, 1); PG8_STAGE(PG8_SB(0, 0), b2, voffB); PG8_STAGE(PG8_SB(0, 1), b2 + hstep, voffB); PG8_STAGE(PG8_SA(0, 0), a2, voffA);
            PG8_WAIT_V(8); PG8_WAIT_L(0); PG8_BAR; PG8_MMA(1, 0, At, B0); PG8_MMA(1, 1, At, B1); PG8_BAR; PG8_SCHED;
            PG8_LDB(B0, 1, 0); PG8_LDB(B1, 1, 1); PG8_SCHED; PG8_LDA(At, 1, 0); PG8_STAGE(PG8_SA(0, 1), a2 + hstep, voffA);
            PG8_WAIT_V(8); PG8_WAIT_L(0); PG8_BAR; PG8_MMA(0, 0, At, B0); PG8_MMA(0, 1, At, B1); PG8_BAR; PG8_SCHED;
            PG8_LDA(At, 1, 1); PG8_STAGE(PG8_SB(1, 0), b3, voffB); PG8_STAGE(PG8_SB(1, 1), b3 + hstep, voffB); PG8_STAGE(PG8_SA(1, 0), a3, voffA);
            PG8_WAIT_V(8); PG8_WAIT_L(0); PG8_BAR; PG8_MMA(1, 0, At, B0); PG8_MMA(1, 1, At, B1); PG8_BAR; PG8_SCHED;
            } else {
            PG8_LDB(B0, 0, 0); PG8_SCHED; PG8_LDA(At, 0, 0); PG8_STAGE(PG8_SA(1, 1), a1 + hstep, voffA);
            PG8_WAIT_L(8); PG8_BAR; PG8_WAIT_L(0); PG8_MMA(0, 0, At, B0); PG8_BAR; PG8_SCHED;
            PG8_LDB(B1, 0, 1); PG8_STAGE(PG8_SB(0, 0), b2, voffB);
            PG8_BAR; PG8_WAIT_L(0); PG8_MMA(0, 1, At, B1); PG8_BAR;
            PG8_LDA(At, 0, 1); PG8_STAGE(PG8_SA(0, 0), a2, voffA);
            PG8_BAR; PG8_WAIT_L(0); PG8_MMA(1, 0, At, B0); PG8_BAR; PG8_SCHED;
            PG8_STAGE(PG8_SB(0, 1), b2 + hstep, voffB);
            PG8_WAIT_V(6); PG8_BAR; PG8_MMA(1, 1, At, B1); PG8_BAR;
            PG8_LDB(B0, 1, 0); PG8_SCHED; PG8_LDA(At, 1, 0); PG8_STAGE(PG8_SA(0, 1), a2 + hstep, voffA);
            PG8_WAIT_L(8); PG8_BAR; PG8_WAIT_L(0); PG8_MMA(0, 0, At, B0); PG8_BAR; PG8_SCHED;
            PG8_LDB(B1, 1, 1); PG8_STAGE(PG8_SB(1, 0), b3, voffB);
            PG8_BAR; PG8_WAIT_L(0); PG8_MMA(0, 1, At, B1); PG8_BAR;
            PG8_LDA(At, 1, 1); PG8_STAGE(PG8_SA(1, 0), a3, voffA);
            PG8_BAR; PG8_WAIT_L(0); PG8_MMA(1, 0, At, B0); PG8_BAR; PG8_SCHED;
            PG8_STAGE(PG8_SB(1, 1), b3 + hstep, voffB);
            PG8_WAIT_V(6); PG8_BAR; PG8_MMA(1, 1, At, B1); PG8_BAR;
            }
        }
        if constexpr (ALIGN_EPI) { if (wr == 0) PG8_BAR; }
        if constexpr (!Epi::AFTER_DRAIN) { E(acc, cur, wr, wc, fr, fq); S.done(cur); }
        if (!has_next) break;
#pragma unroll
        for (int a = 0; a < 2; ++a)
#pragma unroll
            for (int b = 0; b < 2; ++b)
#pragma unroll
                for (int m = 0; m < 4; ++m)
#pragma unroll
                    for (int n = 0; n < 2; ++n) acc[a][b][m][n] = (f32x4){0.f, 0.f, 0.f, 0.f};
        cur = nxt; cA = nA; cB = nB; ++ui;
        if constexpr (ALIGN_EPI) { if (wr == 1) PG8_BAR; }
    }
    PG8_WAIT_V(0);
    if constexpr (!ALIGN_EPI) { if (wr == 0) PG8_BAR; }
    PG8_BAR;
    if constexpr (Epi::AFTER_DRAIN) { E.fused(acc, cur, wr, wc, fr, fq, lds, wid, lane); S.done(cur); }
#undef PG8_SA
#undef PG8_SB
#undef PG8_STAGE
#undef PG8_LDA
#undef PG8_LDB
#undef PG8_MMA
#undef PG8_WAIT_V
#undef PG8_WAIT_L
#undef PG8_BAR
#undef PG8_SCHED
}
}

namespace pg8 {
struct EpiProjF {
    static constexpr bool PERM = true, AFTER_DRAIN = false;
    bf16_t* proj; bf16_t* cmpb;
    __device__ __forceinline__ void operator()(const f32x4 (&acc)[2][2][4][2], const Unit& u, int wr, int wc, int fr, int fq) const {
        const int row0 = u.pm * BM + wr * 64 + fr, colb = u.pn * BM + wc * 32 + 8 * fq;
        const bool iscmp = (u.pn == 6);
#pragma unroll
        for (int ai = 0; ai < 2; ++ai)
#pragma unroll
            for (int m = 0; m < 4; ++m) {
                const int row = row0 + ai * HALF + m * 16;
#pragma unroll
                for (int bj = 0; bj < 2; ++bj) {
                    const f32x4 v0 = acc[ai][bj][m][0], v1 = acc[ai][bj][m][1];
                    u32x4 w; w.x = cvt_pk_bf16(v0[0], v0[1]); w.y = cvt_pk_bf16(v0[2], v0[3]); w.z = cvt_pk_bf16(v1[0], v1[1]); w.w = cvt_pk_bf16(v1[2], v1[3]);
                    const int col = colb + bj * HALF;
                    bf16_t* dst;
                    if (iscmp) { const int c = col - PC_KC, kv = c >> 7, g = (c >> 6) & 1, d = c & 63, b = row >> 13, t = row & (T_ - 1);
                                 dst = cmpb + ((size_t)((kv * B_ + b) * 2 + g) * T_ + t) * 64 + d; }
                    else dst = proj + (size_t)row * NP + col;
                    *(u32x4*)dst = w;
                }
            }
    }
};
struct EpiZF {
    static constexpr bool PERM = true, AFTER_DRAIN = false;
    float* z;
    __device__ __forceinline__ void operator()(const f32x4 (&acc)[2][2][4][2], const Unit& u, int wr, int wc, int fr, int fq) const {
        const int row0 = u.pm * BM + wr * 64 + fr, colb = u.pn * BM + wc * 32 + 8 * fq;
#pragma unroll
        for (int ai = 0; ai < 2; ++ai)
#pragma unroll
            for (int m = 0; m < 4; ++m) {
                float* rp = z + (size_t)(row0 + ai * HALF + m * 16) * D_ + colb;
#pragma unroll
                for (int bj = 0; bj < 2; ++bj) { *(f32x4*)(rp + bj * HALF) = acc[ai][bj][m][0]; *(f32x4*)(rp + bj * HALF + 4) = acc[ai][bj][m][1]; }
            }
    }
};
struct EpiMkvF {
    static constexpr bool PERM = true, AFTER_DRAIN = false;
    bf16_t* o;
    __device__ __forceinline__ void operator()(const f32x4 (&acc)[2][2][4][2], const Unit& u, int wr, int wc, int fr, int fq) const {
        const int row0 = u.pm * BM + wr * 64 + fr, colb = u.pn * BM + wc * 32 + 8 * fq;
#pragma unroll
        for (int ai = 0; ai < 2; ++ai)
#pragma unroll
            for (int m = 0; m < 4; ++m) {
                bf16_t* rp = o + (size_t)(row0 + ai * HALF + m * 16) * 512 + colb;
#pragma unroll
                for (int bj = 0; bj < 2; ++bj) { const f32x4 v0 = acc[ai][bj][m][0], v1 = acc[ai][bj][m][1];
                    u32x4 w; w.x = cvt_pk_bf16(v0[0], v0[1]); w.y = cvt_pk_bf16(v0[2], v0[3]); w.z = cvt_pk_bf16(v1[0], v1[1]); w.w = cvt_pk_bf16(v1[2], v1[3]);
                    *(u32x4*)(rp + bj * HALF) = w; }
            }
    }
};
}

namespace cmpf {
#define CLAS __attribute__((address_space(3)))
typedef short bf16x8 __attribute__((ext_vector_type(8)));
typedef float f32x16 __attribute__((ext_vector_type(16)));
typedef unsigned u32x4 __attribute__((ext_vector_type(4)));
constexpr int LA = 0, LB = 8192, LH = 8192 + 65536, L_BYTES = LH + 16384;
__device__ __forceinline__ void compress_unit(CLAS unsigned char* lds, int& par, const bf16_t* __restrict__ cmpb, const bf16_t* __restrict__ w1img, const float* __restrict__ cb1,
                                              const bf16_t* __restrict__ w2t, bf16_t* __restrict__ kvc, int kv, int bg, int rt, int tid) {
    const int lane = tid & 63, wave = __builtin_amdgcn_readfirstlane(tid >> 6), r32 = lane & 31, hi = lane >> 5;
    const int i0 = 32 * rt;
    const bf16_t* asrc = cmpb + ((size_t)(kv * 8 + bg) * T_ + 16 * (size_t)(i0 + (tid & 31))) * 64 + (tid >> 5) * 8;
    const bf16_t* bsrc = w1img + (size_t)tid * 8;
    f32x16 acc;
#pragma unroll
    for (int r = 0; r < 16; ++r) acc[r] = 0.f;
    u32x4 ra, rb[4];
    if (tid < 256) ra = *(const u32x4*)(asrc);
#pragma unroll
    for (int j = 0; j < 4; ++j) rb[j] = *(const u32x4*)(bsrc + j * 4096);
    for (int kk = 0; kk < 32; ++kk) {
        CLAS unsigned char* la = lds + LA + par * 4096; CLAS unsigned char* lb = lds + LB + par * 32768;
        if (tid < 256) *(CLAS u32x4*)(la + tid * 16) = ra;
#pragma unroll
        for (int j = 0; j < 4; ++j) *(CLAS u32x4*)(lb + (j * 512 + tid) * 16) = rb[j];
        if (kk + 1 < 32) {
            if (tid < 256) ra = *(const u32x4*)(asrc + (kk + 1) * 64);
#pragma unroll
            for (int j = 0; j < 4; ++j) rb[j] = *(const u32x4*)(bsrc + (size_t)(kk + 1) * 16384 + j * 4096);
        }
        __syncthreads();
#pragma unroll
        for (int ds = 0; ds < 4; ++ds) {
            const bf16x8 a = *(const CLAS bf16x8*)(la + (2 * ds + hi) * 512 + r32 * 16);
            const bf16x8 bfr = *(const CLAS bf16x8*)(lb + (2 * ds + hi) * 4096 + (32 * wave + r32) * 16);
            acc = __builtin_amdgcn_mfma_f32_32x32x16_bf16(a, bfr, acc, 0, 0, 0);
        }
        par ^= 1;
    }
    {
        const int n = 32 * wave + r32; const float bias = cb1[n];
        CLAS bf16_t* H = (CLAS bf16_t*)(lds + LH);
#pragma unroll
        for (int r = 0; r < 16; ++r) {
            const int row = (r & 3) + 8 * (r >> 2) + 4 * hi;
            const float x = acc[r] + bias;
            const float u2 = 2.f * 0.7978845608028654f * (x + 0.044715f * x * x * x);
            const float gl = x / (1.f + __builtin_amdgcn_exp2f(-u2 * LOG2E));
            H[(n >> 3) * 256 + row * 8 + (n & 7)] = f2bf(gl);
        }
    }
    __syncthreads();
    if (wave < 2) {
        f32x16 a2;
#pragma unroll
        for (int r = 0; r < 16; ++r) a2[r] = 0.f;
#pragma unroll
        for (int ks = 0; ks < 16; ++ks) {
            const bf16x8 a = *(const CLAS bf16x8*)(lds + LH + (2 * ks + hi) * 512 + r32 * 16);
            const bf16x8 bfr = *(const bf16x8*)(w2t + (size_t)(32 * wave + r32) * 256 + 16 * ks + 8 * hi);
            a2 = __builtin_amdgcn_mfma_f32_32x32x16_bf16(a, bfr, a2, 0, 0, 0);
        }
#pragma unroll
        for (int r = 0; r < 16; ++r) {
            const int i = i0 + (r & 3) + 8 * (r >> 2) + 4 * hi;
            kvc[((size_t)(kv * 8 + bg) * 512 + i) * 64 + 32 * wave + r32] = i == 511 ? (bf16_t)0 : f2bf(a2[r]);
        }
    }
    __syncthreads();
}
__device__ __forceinline__ void compress_phase(CLAS unsigned char* lds, const bf16_t* cmpb, const bf16_t* w1img, const float* cb1, const bf16_t* w2t, bf16_t* kvc) {
    int par = 0;
    const int tid = tid_opaque(), bid = bid_opaque();
    for (int u = bid; u < 256; u += gridDim.x) {
        const int kv = u >> 7, bg = (u >> 4) & 7, rt = u & 15;
        compress_unit(lds, par, cmpb, w1img + (size_t)kv * 524288, cb1 + kv * 256, w2t + (size_t)kv * 16384, kvc, kv, bg, rt, tid);
    }
}
}

namespace misc {
#define MLAS __attribute__((address_space(3)))
typedef unsigned u32x4 __attribute__((ext_vector_type(4)));
__device__ __forceinline__ unsigned pk2(float lo, float hi) { return (unsigned)f2bf(lo) | ((unsigned)f2bf(hi) << 16); }
template <int MODE>
__device__ __forceinline__ void transpose_item(const float* __restrict__ W, int ldsrc, int K, int N, bf16_t* __restrict__ dst, MLAS float* scr, int item, int lane) {
    const int nblk = N / 32, kb = item / nblk, nb = item % nblk, k0 = 64 * kb, n0 = 32 * nb;
    const int n = n0 + (lane & 31);
    int sc = n; float scale = 1.f;
    if (MODE == 1) { sc = orig_col(n); if ((n >= PC_Q && n < PC_Q + 512) || (n >= PC_MQ && n < PC_MQ + 256)) scale = C2; }
#pragma unroll 8
    for (int i = 0; i < 32; ++i) { const int kk = 2 * i + (lane >> 5); scr[kk * 33 + (lane & 31)] = sc >= 0 ? W[(size_t)(k0 + kk) * ldsrc + sc] * scale : 0.f; }
    asm volatile("s_waitcnt lgkmcnt(0)" ::: "memory");
    const int c = lane & 7;
#pragma unroll
    for (int j = 0; j < 4; ++j) {
        const int nn = (lane >> 3) + 8 * j; const MLAS float* s = scr + (8 * c) * 33 + nn;
        u32x4 o; o.x = pk2(s[0 * 33], s[1 * 33]); o.y = pk2(s[2 * 33], s[3 * 33]); o.z = pk2(s[4 * 33], s[5 * 33]); o.w = pk2(s[6 * 33], s[7 * 33]);
        bf16_t* d = MODE == 2 ? dst + ((size_t)((k0 >> 6) * 8 + c) * N + (n0 + nn)) * 8 : dst + (size_t)(n0 + nn) * K + k0 + 8 * c;
        *(u32x4*)d = o;
    }
    asm volatile("s_waitcnt lgkmcnt(0)" ::: "memory");
}
__device__ __forceinline__ void rms_row(const float* __restrict__ xrow, const float* __restrict__ g, bf16_t* __restrict__ orow, int lane) {
    const float4* xr = (const float4*)xrow;
    float4 v[4]; float s = 0.f;
#pragma unroll
    for (int j = 0; j < 4; ++j) { v[j] = xr[lane + 64 * j]; s += v[j].x * v[j].x + v[j].y * v[j].y + v[j].z * v[j].z + v[j].w * v[j].w; }
    const float r = rsqrtf(wave_sum(s) * (1.f / D_) + EPS);
#pragma unroll
    for (int j = 0; j < 4; ++j) {
        const float4 gg = ((const float4*)g)[lane + 64 * j];
        uint2 o; o.x = pk2(v[j].x * r * gg.x, v[j].y * r * gg.y); o.y = pk2(v[j].z * r * gg.z, v[j].w * r * gg.w);
        *(uint2*)(orow + (lane + 64 * j) * 4) = o;
    }
}
__device__ __forceinline__ void resid_row(const float* zrow, const float* xrow, const float* __restrict__ gpost, const float* __restrict__ gnext, float* xorow, bf16_t* xnrow, int lane) {
    const float4* zr = (const float4*)zrow; const float4* xr = (const float4*)xrow;
    float4 v[4]; float s = 0.f;
#pragma unroll
    for (int j = 0; j < 4; ++j) { v[j] = zr[lane + 64 * j]; s += v[j].x * v[j].x + v[j].y * v[j].y + v[j].z * v[j].z + v[j].w * v[j].w; }
    const float r = rsqrtf(wave_sum(s) * (1.f / D_) + EPS);
    float s2 = 0.f;
#pragma unroll
    for (int j = 0; j < 4; ++j) {
        const float4 gg = ((const float4*)gpost)[lane + 64 * j]; const float4 xx = xr[lane + 64 * j];
        v[j].x = xx.x + v[j].x * r * gg.x; v[j].y = xx.y + v[j].y * r * gg.y; v[j].z = xx.z + v[j].z * r * gg.z; v[j].w = xx.w + v[j].w * r * gg.w;
        s2 += v[j].x * v[j].x + v[j].y * v[j].y + v[j].z * v[j].z + v[j].w * v[j].w;
        ((float4*)xorow)[lane + 64 * j] = v[j];
    }
    if (gnext) {
        const float r2 = rsqrtf(wave_sum(s2) * (1.f / D_) + EPS);
#pragma unroll
        for (int j = 0; j < 4; ++j) {
            const float4 gg = ((const float4*)gnext)[lane + 64 * j];
            uint2 o; o.x = pk2(v[j].x * r2 * gg.x, v[j].y * r2 * gg.y); o.y = pk2(v[j].z * r2 * gg.z, v[j].w * r2 * gg.w);
            *(uint2*)(xnrow + (lane + 64 * j) * 4) = o;
        }
    }
}
}

namespace att {
#define ALAS __attribute__((address_space(3)))
typedef short bf16x8 __attribute__((ext_vector_type(8)));
typedef short s16x4 __attribute__((ext_vector_type(4)));
typedef short v4i16_t __attribute__((ext_vector_type(4)));
typedef float f32x16 __attribute__((ext_vector_type(16)));
typedef float f32x4 __attribute__((ext_vector_type(4)));
typedef unsigned u32x4 __attribute__((ext_vector_type(4)));
typedef unsigned u32x2 __attribute__((ext_vector_type(2)));

constexpr int L_K = 0, L_V = 16384, L_IMP = 32768  , L_STG = 65536  ,
              L_WSF = 131072  , L_MASK = 135168, L_WMASK = 136192, L_BYTES = 136320;

__device__ __forceinline__ unsigned cvtpk(float lo, float hi) {
    typedef float f2_t __attribute__((ext_vector_type(2))); typedef __bf16 b2_t __attribute__((ext_vector_type(2)));
    f2_t v = {lo, hi}; b2_t b = __builtin_convertvector(v, b2_t); return __builtin_bit_cast(unsigned, b);
}
__device__ __forceinline__ s16x4 vtr(const ALAS unsigned char* p) { return __builtin_bit_cast(s16x4, __builtin_amdgcn_ds_read_tr16_b64_v4i16((ALAS v4i16_t*)p)); }
__device__ __forceinline__ float dpp_xor1(float v) { return __builtin_bit_cast(float, __builtin_amdgcn_update_dpp(0, __builtin_bit_cast(int, v), 0xB1, 0xF, 0xF, true)); }
__device__ __forceinline__ float dpp_xor2(float v) { return __builtin_bit_cast(float, __builtin_amdgcn_update_dpp(0, __builtin_bit_cast(int, v), 0x4E, 0xF, 0xF, true)); }
__device__ __forceinline__ float swap32_max(float m) { auto rr = __builtin_amdgcn_permlane32_swap(__float_as_uint(m), __float_as_uint(m), false, false); return fmaxf(__uint_as_float(rr[0]), __uint_as_float(rr[1])); }
__device__ __forceinline__ float swap32_sum(float m) { auto rr = __builtin_amdgcn_permlane32_swap(__float_as_uint(m), __float_as_uint(m), false, false); return __uint_as_float(rr[0]) + __uint_as_float(rr[1]); }
__device__ __forceinline__ void wg_barrier() { __syncthreads(); }

struct WaveSt { bf16x8 qf[4]; f32x16 o0, o1; float m, l; };
struct TReg { u32x4 k, v; };

__device__ __forceinline__ void ld_k(TReg& R, const bf16_t* kp, int pitch, int wave, int lane) { R.k = *(const u32x4*)(kp + (size_t)lane * pitch + wave * 8); }
__device__ __forceinline__ void ld_v(TReg& R, const bf16_t* vp, int pitch, int wave, int lane) { R.v = *(const u32x4*)(vp + (size_t)(16 * (wave & 3) + (lane >> 2)) * pitch + (wave >> 2) * 32 + (lane & 3) * 8); }
__device__ __forceinline__ void st_k(const TReg& R, ALAS unsigned char* ks, int tid) { *(ALAS u32x4*)(ks + tid * 16) = R.k; }
__device__ __forceinline__ void st_v(const TReg& R, ALAS unsigned char* vs, int tid) { *(ALAS u32x4*)(vs + tid * 16) = R.v; }

constexpr float THR = 8.f, M_INIT = -1024.f;
template <int MODE, bool BIAS>
__device__ __forceinline__ void att_step(const ALAS unsigned char* Ks, const ALAS unsigned char* Vs, WaveSt& S, ALAS float* wsf, int lane, int r32, int hi,
                                         bool masked, float mthr, float mG, float slope2, float ksf, int tq, bool rowok, float inv_l, f32x16& p0, f32x16& p1) {
    if (BIAS) {
        const float sk = slope2 * ksf, e1 = sk, e2 = 2.f * sk, e3 = 3.f * sk;
        const float base0 = rowok ? (sk * (float)(4 * hi) - slope2 * (float)tq - S.m) : -INFINITY;
#pragma unroll
        for (int a = 0; a < 4; ++a) {
            const float b0 = base0 + (float)(8 * a) * sk, b1 = base0 + (float)(8 * a + 32) * sk;
            p0[4 * a] = b0; p0[4 * a + 1] = b0 + e1; p0[4 * a + 2] = b0 + e2; p0[4 * a + 3] = b0 + e3;
            p1[4 * a] = b1; p1[4 * a + 1] = b1 + e1; p1[4 * a + 2] = b1 + e2; p1[4 * a + 3] = b1 + e3;
        }
        if (masked) {
            const float mC = -(mthr - S.m) * mG;
#pragma unroll
            for (int r = 0; r < 16; ++r) { p0[r] += fminf(fmaf(p0[r], mG, mC), 0.f); p1[r] += fminf(fmaf(p1[r], mG, mC), 0.f); }
        }
    } else {
        const float nm = -S.m;
#pragma unroll
        for (int r = 0; r < 16; ++r) { p0[r] = nm; p1[r] = nm; }
    }
    const ALAS unsigned char* kb = Ks + hi * 1024 + r32 * 16;
#pragma unroll
    for (int ds = 0; ds < 4; ++ds) {
        const bf16x8 a0 = *(const ALAS bf16x8*)(kb + ds * 2048), a1 = *(const ALAS bf16x8*)(kb + ds * 2048 + 512);
        p0 = __builtin_amdgcn_mfma_f32_32x32x16_bf16(a0, S.qf[ds], p0, 0, 0, 0);
        p1 = __builtin_amdgcn_mfma_f32_32x32x16_bf16(a1, S.qf[ds], p1, 0, 0, 0);
    }
    if (MODE == 2) {
#pragma unroll
        for (int r = 0; r < 16; ++r) { p0[r] = __builtin_amdgcn_exp2f(p0[r]) * inv_l; p1[r] = __builtin_amdgcn_exp2f(p1[r]) * inv_l; }
    } else {
        float ma = fmaxf(fmaxf(p0[0], p0[1]), p1[0]), mb = fmaxf(fmaxf(p0[2], p0[3]), p1[1]);
        ma = fmaxf(fmaxf(ma, p1[2]), p1[3]);
#pragma unroll
        for (int r = 4; r < 16; r += 4) { ma = fmaxf(fmaxf(ma, p0[r]), p0[r + 1]); mb = fmaxf(fmaxf(mb, p0[r + 2]), p0[r + 3]); ma = fmaxf(fmaxf(ma, p1[r]), p1[r + 1]); mb = fmaxf(fmaxf(mb, p1[r + 2]), p1[r + 3]); }
        const float rm = swap32_max(fmaxf(ma, mb));
        if (__any(rm > THR)) {
            const float dl = fmaxf(rm, 0.f);
            S.m += dl;
#pragma unroll
            for (int r = 0; r < 16; ++r) { p0[r] -= dl; p1[r] -= dl; }
            const float f = __builtin_amdgcn_exp2f(-dl);
            S.l *= f;
            if (MODE == 0) {
                if (hi == 0) wsf[r32] = f;
#pragma unroll
                for (int a = 0; a < 4; ++a) {
                    const f32x4 ff = *(const ALAS f32x4*)(wsf + 8 * a + 4 * hi);
#pragma unroll
                    for (int i = 0; i < 4; ++i) { S.o0[4 * a + i] *= ff[i]; S.o1[4 * a + i] *= ff[i]; }
                }
            }
        }
        typedef float f2v __attribute__((ext_vector_type(2)));
        f2v acc2 = {0.f, 0.f};
#pragma unroll
        for (int r = 0; r < 16; r += 2) {
            p0[r] = __builtin_amdgcn_exp2f(p0[r]); p0[r + 1] = __builtin_amdgcn_exp2f(p0[r + 1]); p1[r] = __builtin_amdgcn_exp2f(p1[r]); p1[r + 1] = __builtin_amdgcn_exp2f(p1[r + 1]);
            acc2 += (f2v){p0[r], p0[r + 1]}; acc2 += (f2v){p1[r], p1[r + 1]};
        }
        S.l += acc2.x + acc2.y;
        if (MODE == 1) return;
    }
    u32x4 pw[4];
    pw[0] = (u32x4){cvtpk(p0[0], p0[1]), cvtpk(p0[2], p0[3]), cvtpk(p0[4], p0[5]), cvtpk(p0[6], p0[7])};
    pw[1] = (u32x4){cvtpk(p0[8], p0[9]), cvtpk(p0[10], p0[11]), cvtpk(p0[12], p0[13]), cvtpk(p0[14], p0[15])};
    pw[2] = (u32x4){cvtpk(p1[0], p1[1]), cvtpk(p1[2], p1[3]), cvtpk(p1[4], p1[5]), cvtpk(p1[6], p1[7])};
    pw[3] = (u32x4){cvtpk(p1[8], p1[9]), cvtpk(p1[10], p1[11]), cvtpk(p1[12], p1[13]), cvtpk(p1[14], p1[15])};
    const ALAS unsigned char* vb = Vs + ((lane >> 4) & 1) * 32 + (lane & 3) * 8 + (4 * hi + ((lane & 15) >> 2)) * 64;
#pragma unroll
    for (int ks = 0; ks < 4; ++ks) {
        const bf16x8 pa = __builtin_bit_cast(bf16x8, pw[ks]);
        const s16x4 l0 = vtr(vb + ks * 1024), h0 = vtr(vb + ks * 1024 + 512);
        const s16x4 l1 = vtr(vb + 4096 + ks * 1024), h1 = vtr(vb + 4096 + ks * 1024 + 512);
        const bf16x8 v0 = (bf16x8){l0[0], l0[1], l0[2], l0[3], h0[0], h0[1], h0[2], h0[3]};
        const bf16x8 v1 = (bf16x8){l1[0], l1[1], l1[2], l1[3], h1[0], h1[1], h1[2], h1[3]};
        S.o0 = __builtin_amdgcn_mfma_f32_32x32x16_bf16(pa, v0, S.o0, 0, 0, 0);
        S.o1 = __builtin_amdgcn_mfma_f32_32x32x16_bf16(pa, v1, S.o1, 0, 0, 0);
    }
}
template <bool FIRST>
__device__ __forceinline__ void fold(WaveSt& S, ALAS float* stg, float f_row, ALAS float* wsf, int r32, int hi) {
    if (hi == 0) wsf[r32] = f_row;
#pragma unroll
    for (int a = 0; a < 4; ++a) {
        const f32x4 f = *(const ALAS f32x4*)(wsf + 8 * a + 4 * hi);
#pragma unroll
        for (int i = 0; i < 4; ++i) {
            const int idx = (8 * a + 4 * hi + i) * 64 + r32;
            if (FIRST) { stg[idx] = S.o0[4 * a + i] * f[i]; stg[idx + 32] = S.o1[4 * a + i] * f[i]; }
            else { stg[idx] += S.o0[4 * a + i] * f[i]; stg[idx + 32] += S.o1[4 * a + i] * f[i]; }
        }
    }
#pragma unroll
    for (int r = 0; r < 16; ++r) { S.o0[r] = 0.f; S.o1[r] = 0.f; }
}

template <class RowMap>
__device__ __forceinline__ void store_rows(ALAS float* stg  , int lane, const RowMap& rm) {
#pragma unroll
    for (int i = 0; i < 4; ++i) {
        const int row = i * 8 + (lane >> 3), ch = lane & 7;
        const f32x4 a = *(const ALAS f32x4*)(stg + row * 64 + ch * 8), c = *(const ALAS f32x4*)(stg + row * 64 + ch * 8 + 4);
        const bf16_t* gp; bf16_t* yp; rm(row, gp, yp);
        const u32x4 gv = *(const u32x4*)(gp + ch * 8);
        const unsigned gw[4] = {gv.x, gv.y, gv.z, gv.w};
        const float ov[8] = {a[0], a[1], a[2], a[3], c[0], c[1], c[2], c[3]};
        unsigned ow[4];
#pragma unroll
        for (int j = 0; j < 4; ++j) {
            const float glo = __uint_as_float(gw[j] << 16), ghi = __uint_as_float(gw[j] & 0xffff0000u);
            ow[j] = cvtpk(ov[2 * j] * silu_f(glo), ov[2 * j + 1] * silu_f(ghi));
        }
        *(u32x4*)(yp + ch * 8) = (u32x4){ow[0], ow[1], ow[2], ow[3]};
    }
}

struct NsaRowMap { const bf16_t* proj; bf16_t* Y; int b, g, tbase;
    __device__ __forceinline__ void operator()(int row, const bf16_t*& gp, bf16_t*& yp) const {
        const size_t m = (size_t)b * T_ + tbase + (row >> 2); const int hd = g * 4 + (row & 3);
        gp = proj + m * NP + PC_NG + hd * 64; yp = Y + m * D_ + 256 + hd * 64; } };
struct MemRowMap { const bf16_t* proj; bf16_t* Y; int b, mh, tbase;
    __device__ __forceinline__ void operator()(int row, const bf16_t*& gp, bf16_t*& yp) const {
        const size_t m = (size_t)b * T_ + tbase + row;
        gp = proj + m * NP + PC_MG + mh * 64; yp = Y + m * D_ + 768 + mh * 64; } };

__device__ __forceinline__ void nsa_unit(ALAS unsigned char* lds, int& par, const bf16_t* __restrict__ proj, const bf16_t* __restrict__ kvc, const float* __restrict__ bgate, bf16_t* __restrict__ Y, int b, int g, int qb, int tid) {
    const int lane = tid & 63, wave = __builtin_amdgcn_readfirstlane(tid >> 6), r32 = lane & 31, hi = lane >> 5;
    const int q0 = qb * 64, qi = r32 >> 2, hh = r32 & 3, head = g * 4 + hh, t_row = q0 + 8 * wave + qi;
    const float slope2 = exp2f(-(float)(head + 1)) * LOG2E;
    const bf16_t* prow = proj + (size_t)(b * T_ + t_row) * NP;
    WaveSt S;
#pragma unroll
    for (int ds = 0; ds < 4; ++ds) S.qf[ds] = *(const bf16x8*)(prow + PC_Q + head * 64 + ds * 16 + hi * 8);
    ALAS float* wsf = (ALAS float*)(lds + L_WSF) + wave * 128;
    ALAS float* imp = (ALAS float*)(lds + L_IMP) + wave * 1024;
    if (hi == 0) {
        wsf[32 + r32] = sigmoid_f(bf2f(prow[PC_GL + head]) + bgate[head]);
        wsf[64 + r32] = sigmoid_f(bf2f(prow[PC_GL + 8 + head]) + bgate[8 + head]);
        wsf[96 + r32] = sigmoid_f(bf2f(prow[PC_GL + 16 + head]) + bgate[16 + head]);
    }
    ALAS float* stg = (ALAS float*)(lds + L_STG) + wave * 2048;
    ALAS unsigned char* Kl = lds + L_K; ALAS unsigned char* Vl = lds + L_V;
    f32x16 p0, p1;
#pragma unroll
    for (int r = 0; r < 16; ++r) { S.o0[r] = 0.f; S.o1[r] = 0.f; }
    const bf16_t* kc = kvc + (size_t)((0 * B_ + b) * 2 + g) * 512 * 64;
    const bf16_t* vc = kvc + (size_t)((1 * B_ + b) * 2 + g) * 512 * 64;
    const int nvmax = min((q0 + 63 - 31) / 16 + 1, 511), ntc = (nvmax + 63) >> 6;
    TReg R;
    const int tmin = q0 + 8 * wave;
    S.m = M_INIT; S.l = 0.f;
    ld_k(R, kc, 64, wave, lane);
    for (int jt = 0; jt < ntc; ++jt) {
        st_k(R, Kl + par * 8192, tid);
        if (jt + 1 < ntc) ld_k(R, kc + (size_t)(jt + 1) * 4096, 64, wave, lane);
        wg_barrier();
        att_step<1, true>(Kl + par * 8192, Vl, S, wsf, lane, r32, hi, 1024 * jt + 1039 > tmin, 0.5f * slope2, -1e30f, slope2, 16.f, t_row - (1024 * jt + 31), true, 0.f, p0, p1);
        par ^= 1;
    }
    const float l_c = swap32_sum(S.l);
    const float inv_l = l_c > 0.f ? 1.f / l_c : 0.f;
    float carry = 0.f;
    ld_k(R, kc, 64, wave, lane); ld_v(R, vc, 64, wave, lane);
    for (int jt = 0; jt < ntc; ++jt) {
        st_k(R, Kl + par * 8192, tid); st_v(R, Vl + par * 8192, tid);
        if (jt + 1 < ntc) { ld_k(R, kc + (size_t)(jt + 1) * 4096, 64, wave, lane); ld_v(R, vc + (size_t)(jt + 1) * 4096, 64, wave, lane); }
        wg_barrier();
        att_step<2, true>(Kl + par * 8192, Vl + par * 8192, S, wsf, lane, r32, hi, 1024 * jt + 1039 > tmin, 0.5f * slope2, -1e30f, slope2, 16.f, t_row - (1024 * jt + 31), true, inv_l, p0, p1);
        par ^= 1;
#ifndef EXP_NOIMP
        {
            float Av[8], Bv[8];
#pragma unroll
            for (int u = 0; u < 2; ++u)
#pragma unroll
                for (int a = 0; a < 4; ++a) {
                    const float x0 = u ? p1[4 * a] : p0[4 * a], x1 = u ? p1[4 * a + 1] : p0[4 * a + 1], x2 = u ? p1[4 * a + 2] : p0[4 * a + 2], x3 = u ? p1[4 * a + 3] : p0[4 * a + 3];
                    float A = 2.f * (x0 + x1 + x2) + x3, B = x3;
                    A += dpp_xor1(A); A += dpp_xor2(A); B += dpp_xor1(B); B += dpp_xor2(B);
                    Av[u * 4 + a] = A; Bv[u * 4 + a] = B;
                }
            float prevB[8];
#pragma unroll
            for (int i = 0; i < 8; ++i) {
                const float mine_lo = Bv[i];
                const float mine_hi = i == 0 ? carry : Bv[i - 1];
                const float give = hi ? mine_hi : mine_lo;
                auto rr = __builtin_amdgcn_permlane32_swap(__float_as_uint(give), __float_as_uint(give), false, false);
                prevB[i] = __uint_as_float(hi ? rr[0] : rr[1]);
            }
            carry = Bv[7];
            if (hh == 0) {
#pragma unroll
                for (int i = 0; i < 8; ++i) imp[qi * 128 + 16 * jt + 8 * (i >> 2) + 2 * (i & 3) + hi] = Av[i] + prevB[i];
            }
        }
#endif
    }
    fold<true>(S, stg, wsf[32 + r32], wsf, r32, hi);
    const int cur = qb;
    unsigned long long um_a = 0ull, um_b = 0ull;
    {
        const int ncand = cur >= 2 ? cur - 2 : 0, nforced = cur >= 2 ? 3 : cur + 1, need = 16 - nforced;
        unsigned long long fa = 1ull, fb = 0ull;
        if (cur < 64) fa |= 1ull << cur; else fb |= 1ull << (cur - 64);
        if (cur >= 1) { if (cur - 1 < 64) fa |= 1ull << (cur - 1); else fb |= 1ull << (cur - 65); }
        ALAS u32x4* selm = (ALAS u32x4*)(lds + L_MASK);
#ifdef EXP_NOTOPK
        if (true) {
#else
        if (ncand <= need) {
#endif
            const unsigned long long ma = cur >= 63 ? ~0ull : ((1ull << (cur + 1)) - 1ull);
            um_a = ma; um_b = 0ull;
            if (lane < 8) selm[8 * wave + lane] = (u32x4){(unsigned)ma, (unsigned)(ma >> 32), 0u, 0u};
        } else {
            const bool ca = lane >= 1 && lane <= cur - 2, cb = lane + 64 <= cur - 2;
            for (int q = 0; q < 8; ++q) {
                const unsigned ua = __float_as_uint(imp[q * 128 + lane]);
                const unsigned ub = __float_as_uint(imp[q * 128 + 64 + lane]);
                unsigned tau = 0u; unsigned long long ga = 0ull, gb = 0ull; bool exact = false;
                for (int bit = 30; bit >= 0; --bit) {
                    const unsigned c = tau | (1u << bit);
                    const unsigned long long xa = __ballot(ca && ua >= c), xb = __ballot(cb && ub >= c);
                    const int cnt = __popcll(xa) + __popcll(xb);
                    if (cnt >= need) { tau = c; if (cnt == need) { ga = xa; gb = xb; exact = true; break; } }
                }
                if (!exact) {
                    ga = __ballot(ca && ua > tau); gb = __ballot(cb && ub > tau);
                    unsigned long long ea = __ballot(ca && ua == tau), eb = __ballot(cb && ub == tau);
                    int rem = need - __popcll(ga) - __popcll(gb);
                    while (rem > 0 && ea) { ga |= ea & (0ull - ea); ea &= ea - 1ull; --rem; }
                    while (rem > 0 && eb) { gb |= eb & (0ull - eb); eb &= eb - 1ull; --rem; }
                }
                ga |= fa; gb |= fb;
                um_a |= ga; um_b |= gb;
                if (lane == 0) selm[8 * wave + q] = (u32x4){(unsigned)ga, (unsigned)(ga >> 32), (unsigned)gb, (unsigned)(gb >> 32)};
            }
        }
        if (lane == 0) ((ALAS u32x4*)(lds + L_WMASK))[wave] = (u32x4){(unsigned)um_a, (unsigned)(um_a >> 32), (unsigned)um_b, (unsigned)(um_b >> 32)};
    }
    {
        const size_t kwo = (size_t)b * T_ * NP + PC_KW + g * 64, vwo = (size_t)b * T_ * NP + PC_VW + g * 64;
        const int wlo = qb >= 8 ? qb - 8 : 0;
        S.m = M_INIT; S.l = 0.f;
        ld_k(R, proj + kwo + (size_t)wlo * 64 * NP, NP, wave, lane); ld_v(R, proj + vwo + (size_t)wlo * 64 * NP, NP, wave, lane);
        for (int blk = wlo; blk <= qb; ++blk) {
            st_k(R, Kl + par * 8192, tid); st_v(R, Vl + par * 8192, tid);
            if (blk + 1 <= qb) { ld_k(R, proj + kwo + (size_t)(blk + 1) * 64 * NP, NP, wave, lane); ld_v(R, proj + vwo + (size_t)(blk + 1) * 64 * NP, NP, wave, lane); }
            wg_barrier();
            att_step<0, true>(Kl + par * 8192, Vl + par * 8192, S, wsf, lane, r32, hi, blk == qb || blk + 8 == qb, blk == qb ? 0.5f * slope2 : -511.5f * slope2, blk == qb ? -1e30f : 1e30f, slope2, 1.f, t_row - 64 * blk, true, 0.f, p0, p1);
            par ^= 1;
        }
        const float l_w = swap32_sum(S.l);
        fold<false>(S, stg, wsf[96 + r32] / l_w, wsf, r32, hi);
    }
    {
        unsigned long long ua = 0ull, ub = 0ull;
        {
            const ALAS u32x4* wm = (const ALAS u32x4*)(lds + L_WMASK);
#pragma unroll
            for (int w = 0; w < 8; ++w) { const u32x4 v = wm[w]; ua |= (unsigned long long)v.x | ((unsigned long long)v.y << 32); ub |= (unsigned long long)v.z | ((unsigned long long)v.w << 32); }
            ua = ((unsigned long long)__builtin_amdgcn_readfirstlane((unsigned)(ua >> 32)) << 32) | (unsigned)__builtin_amdgcn_readfirstlane((unsigned)ua);
            ub = ((unsigned long long)__builtin_amdgcn_readfirstlane((unsigned)(ub >> 32)) << 32) | (unsigned)__builtin_amdgcn_readfirstlane((unsigned)ub);
        }
        const size_t kso = (size_t)b * T_ * NP + PC_KS + g * 64, vso = (size_t)b * T_ * NP + PC_VS + g * 64;
        S.m = M_INIT; S.l = 0.f;
        int blk = ua ? __ffsll((long long)ua) - 1 : (ub ? 64 + __ffsll((long long)ub) - 1 : -1);
        if (blk >= 0) { if (blk < 64) ua &= ua - 1ull; else ub &= ub - 1ull; }
        if (blk >= 0) { ld_k(R, proj + kso + (size_t)blk * 64 * NP, NP, wave, lane); ld_v(R, proj + vso + (size_t)blk * 64 * NP, NP, wave, lane); }
        while (blk >= 0) {
            int nxt = ua ? __ffsll((long long)ua) - 1 : (ub ? 64 + __ffsll((long long)ub) - 1 : -1);
            if (nxt >= 0) { if (nxt < 64) ua &= ua - 1ull; else ub &= ub - 1ull; }
            st_k(R, Kl + par * 8192, tid); st_v(R, Vl + par * 8192, tid);
            if (nxt >= 0) { ld_k(R, proj + kso + (size_t)nxt * 64 * NP, NP, wave, lane); ld_v(R, proj + vso + (size_t)nxt * 64 * NP, NP, wave, lane); }
            wg_barrier();
            const bool wsel = blk < 64 ? ((um_a >> blk) & 1ull) : ((um_b >> (blk - 64)) & 1ull);
            if (wsel) {
                const bool rowok = (((const ALAS unsigned*)(lds + L_MASK))[(8 * wave + qi) * 4 + (blk >> 5)] >> (blk & 31)) & 1u;
                att_step<0, true>(Kl + par * 8192, Vl + par * 8192, S, wsf, lane, r32, hi, blk == qb, 0.5f * slope2, -1e30f, slope2, 1.f, t_row - 64 * blk, rowok, 0.f, p0, p1);
            }
            par ^= 1;
            blk = nxt;
        }
        const float l_s = swap32_sum(S.l);
        fold<false>(S, stg, wsf[64 + r32] / l_s, wsf, r32, hi);
    }
    store_rows(stg, lane, NsaRowMap{proj, Y, b, g, q0 + 8 * wave});
}

__device__ __forceinline__ void mem_unit(ALAS unsigned char* lds, int& par, const bf16_t* __restrict__ proj, const bf16_t* __restrict__ mkv, bf16_t* __restrict__ Y, int b, int mh, int qb, int tid) {
    const int lane = tid & 63, wave = __builtin_amdgcn_readfirstlane(tid >> 6), r32 = lane & 31, hi = lane >> 5;
    const int t_row = qb * 256 + 32 * wave + r32;
    const bf16_t* prow = proj + (size_t)(b * T_ + t_row) * NP;
    WaveSt S;
#pragma unroll
    for (int ds = 0; ds < 4; ++ds) S.qf[ds] = *(const bf16x8*)(prow + PC_MQ + mh * 64 + ds * 16 + hi * 8);
    ALAS float* wsf = (ALAS float*)(lds + L_WSF) + wave * 128;
    ALAS unsigned char* Kl = lds + L_K; ALAS unsigned char* Vl = lds + L_V;
    ALAS float* stg = (ALAS float*)(lds + L_STG) + wave * 2048;
    f32x16 p0, p1;
#pragma unroll
    for (int r = 0; r < 16; ++r) { S.o0[r] = 0.f; S.o1[r] = 0.f; }
    S.m = M_INIT; S.l = 0.f;
    const bf16_t* kp = mkv + (size_t)(b * NMEM) * 512 + mh * 64; const bf16_t* vp = kp + 256;
    TReg R;
    ld_k(R, kp, 512, wave, lane); ld_v(R, vp, 512, wave, lane);
    for (int jt = 0; jt < 4; ++jt) {
        st_k(R, Kl + par * 8192, tid); st_v(R, Vl + par * 8192, tid);
        if (jt + 1 < 4) { ld_k(R, kp + (size_t)(jt + 1) * 64 * 512, 512, wave, lane); ld_v(R, vp + (size_t)(jt + 1) * 64 * 512, 512, wave, lane); }
        wg_barrier();
        att_step<0, false>(Kl + par * 8192, Vl + par * 8192, S, wsf, lane, r32, hi, false, 0.f, 0.f, 0.f, 0.f, 0, true, 0.f, p0, p1);
        par ^= 1;
    }
    const float l_m = swap32_sum(S.l);
    fold<true>(S, stg, 1.f / l_m, wsf, r32, hi);
    store_rows(stg, lane, MemRowMap{proj, Y, b, mh, qb * 256 + 32 * wave});
}

__device__ __forceinline__ void conv_rows(const bf16_t* __restrict__ proj, const float* __restrict__ cw, const float* __restrict__ cb, bf16_t* __restrict__ Y, int r0, int nrows, int tid) {
    for (int item = tid; item < nrows * 32; item += 512) {
        const int m = r0 + (item >> 5), ch = item & 31, t = m & (T_ - 1), c0 = ch * 8;
        const bf16_t* p = proj + (size_t)m * NP;
        const u32x4 vb = *(const u32x4*)(p + PC_CB + c0), vg = *(const u32x4*)(p + PC_CG + c0);
        float acc[8];
#pragma unroll
        for (int j = 0; j < 8; ++j) acc[j] = cb[c0 + j];
#pragma unroll
        for (int k = 0; k < 3; ++k) {
            if (t - 2 + k >= 0) {
                const bf16_t* pp = p - (size_t)(2 - k) * NP;
                const u32x4 vc = *(const u32x4*)(pp + PC_CC + c0), vh = *(const u32x4*)(pp + PC_CH + c0);
                const unsigned cwv[4] = {vc.x, vc.y, vc.z, vc.w}, hwv[4] = {vh.x, vh.y, vh.z, vh.w};
#pragma unroll
                for (int j = 0; j < 4; ++j) {
                    acc[2 * j] += cw[k * 256 + c0 + 2 * j] * __uint_as_float(cwv[j] << 16) * __uint_as_float(hwv[j] << 16);
                    acc[2 * j + 1] += cw[k * 256 + c0 + 2 * j + 1] * __uint_as_float(cwv[j] & 0xffff0000u) * __uint_as_float(hwv[j] & 0xffff0000u);
                }
            }
        }
        const unsigned bw[4] = {vb.x, vb.y, vb.z, vb.w}, gw[4] = {vg.x, vg.y, vg.z, vg.w};
        unsigned ow[4];
#pragma unroll
        for (int j = 0; j < 4; ++j)
            ow[j] = cvtpk(__uint_as_float(bw[j] << 16) * acc[2 * j] * silu_f(__uint_as_float(gw[j] << 16)),
                          __uint_as_float(bw[j] & 0xffff0000u) * acc[2 * j + 1] * silu_f(__uint_as_float(gw[j] & 0xffff0000u)));
        *(u32x4*)(Y + (size_t)m * D_ + c0) = (u32x4){ow[0], ow[1], ow[2], ow[3]};
    }
}

__device__ __forceinline__ void att_phase(ALAS unsigned char* lds, const bf16_t* proj, const bf16_t* kvc, const bf16_t* mkv, const float* bgate, const float* cw, const float* cb, bf16_t* Y) {
    int par = 0;
    const int G = gridDim.x, tid = tid_opaque(), bid = bid_opaque();
    for (int u = bid; u < 1024; u += G) {
        const int bg = u & 7, s = (u >> 3) & 31, k = u >> 8;
        const int qb = k == 0 ? s : k == 1 ? 63 - s : k == 2 ? 64 + s : 127 - s;
        nsa_unit(lds, par, proj, kvc, bgate, Y, bg >> 1, bg & 1, qb, tid);
    }
    for (int u = bid; u < 512; u += G) mem_unit(lds, par, proj, mkv, Y, u >> 7, (u >> 5) & 3, u & 31, tid);
    for (int r0 = bid * 128; r0 < M_; r0 += G * 128) conv_rows(proj, cw, cb, Y, r0, 128, tid);
}
}

#define LAS __attribute__((address_space(3)))
#define XB_TMO      128
#define XB_XCNT(j)  (256  + 64 * (j))
#define XB_XSUB(j)  (1280 + 64 * (j))
#define XB_XGEN(j)  (2304 + 64 * (j))
#define XB_TOP      3328
#define XB_TOPGEN   3392
#define XCD_BAR_WORDS 3456
#define XB_SPIN_CAP (1u << 18)
__device__ __forceinline__ unsigned xb_ld(unsigned* p)              { return __hip_atomic_load(p, __ATOMIC_RELAXED, __HIP_MEMORY_SCOPE_AGENT); }
__device__ __forceinline__ unsigned xb_add(unsigned* p, unsigned v) { return __hip_atomic_fetch_add(p, v, __ATOMIC_RELAXED, __HIP_MEMORY_SCOPE_AGENT); }
__device__ __forceinline__ unsigned xb_xcc_id() { return (unsigned)__builtin_amdgcn_s_getreg((3 << 11) | 20) & 0xFu; }
#define XB_SPIN(cond, bar) do { unsigned _sp = 0; while (cond) { __builtin_amdgcn_s_sleep(1); \
    if ((++_sp & 255u) == 0u) { if (xb_ld(&(bar)[XB_TMO])) break; if (_sp > XB_SPIN_CAP) { atomicAdd(&(bar)[XB_TMO], 1u); break; } } } } while (0)
struct XcdBarrier { unsigned* bar; unsigned x; volatile LAS unsigned* st; };
__device__ __forceinline__ XcdBarrier xcd_barrier_post(unsigned* bar, volatile LAS unsigned* st) {
    XcdBarrier b; b.bar = bar; b.x = xb_xcc_id(); b.st = st;
    if (threadIdx.x == 0) (void)xb_add(&bar[XB_XCNT(b.x)], 1u);
    return b;
}
__device__ __forceinline__ void xcd_barrier_complete(unsigned* bar, unsigned x, unsigned& nloc, unsigned& nx) {
    const unsigned G = gridDim.x * gridDim.y * gridDim.z;
    unsigned sum, cnt, mine, sp = 0u;
    for (;;) {
        sum = 0u; cnt = 0u; mine = 0u;
#pragma unroll
        for (unsigned j = 0; j < 16; ++j) { const unsigned c = xb_ld(&bar[XB_XCNT(j)]); sum += c; cnt += (c > 0u) ? 1u : 0u; mine = (j == x) ? c : mine; }
        if (sum == G) break;
        __builtin_amdgcn_s_sleep(1);
        if ((++sp & 255u) == 0u) { if (xb_ld(&bar[XB_TMO])) break; if (sp > XB_SPIN_CAP) { atomicAdd(&bar[XB_TMO], 1u); break; } }
    }
    nloc = mine > 0u ? mine : 1u; nx = cnt > 0u ? cnt : 1u;
}
__device__ __forceinline__ void xcd_barrier(const XcdBarrier& b) {
    asm volatile("s_waitcnt vmcnt(0)" ::: "memory");
    __syncthreads();
    if (threadIdx.x == 0) {
        unsigned* bar = b.bar;
        __builtin_amdgcn_s_waitcnt(0);
        unsigned nloc = b.st[0], nx = b.st[1];
        if (nloc == 0u) { xcd_barrier_complete(bar, b.x, nloc, nx); b.st[0] = nloc; b.st[1] = nx; }
        const unsigned old = xb_add(&bar[XB_XSUB(b.x)], 1u);
        const unsigned gen = old / nloc;
        if (old + 1u == (gen + 1u) * nloc) {
            __builtin_amdgcn_fence(__ATOMIC_RELEASE, "agent");
            asm volatile("s_waitcnt vmcnt(0)" ::: "memory");
            const unsigned og = xb_add(&bar[XB_TOP], 1u);
            const unsigned tg = og / nx;
            if (og + 1u == (tg + 1u) * nx) xb_add(&bar[XB_TOPGEN], 1u);
            else XB_SPIN(xb_ld(&bar[XB_TOPGEN]) == tg, bar);
            __builtin_amdgcn_fence(__ATOMIC_ACQUIRE, "agent");
            xb_add(&bar[XB_XGEN(b.x)], 1u);
            asm volatile("s_waitcnt vmcnt(0)" ::: "memory");
        } else {
            XB_SPIN(xb_ld(&bar[XB_XGEN(b.x)]) == gen, bar);
            __builtin_amdgcn_fence(__ATOMIC_ACQUIRE, "agent");
            asm volatile("s_waitcnt vmcnt(0)" ::: "memory");
        }
    }
    __syncthreads();
}

constexpr int LDS_BYTES = 147456;
constexpr int RING_BYTES = 143360, MISC_OFF = RING_BYTES + 320;
static_assert(att::L_BYTES <= RING_BYTES && cmpf::L_BYTES <= RING_BYTES && pg8::STAGE_BYTES <= RING_BYTES, "LDS map");
constexpr int NPHASE = 1 + 5 * L_;
constexpr size_t WS_CTL = WS_END;
constexpr size_t CTL_BYTES = 65536;
constexpr size_t WS_TOTAL = WS_CTL + CTL_BYTES;

struct Args { const float* in[17]; float* out; unsigned char* ws; int ph_lo, ph_hi, use_bar, pad; };

__global__ void __launch_bounds__(512, 2) mega(Args a) {
    extern __shared__ __attribute__((aligned(16))) unsigned char lds_raw[];
    LAS unsigned char* lds = (LAS unsigned char*)lds_raw;
    const int G = gridDim.x;
    volatile LAS unsigned* MISC = (volatile LAS unsigned*)(lds + MISC_OFF);
    for (int u = threadIdx.x; u < (LDS_BYTES - RING_BYTES) / 4; u += 512) ((LAS unsigned*)(lds + RING_BYTES))[u] = 0u;
    __syncthreads();
    unsigned char* ws = a.ws;
    XcdBarrier bar; bar.bar = (unsigned*)(ws + WS_CTL) + 4096; bar.x = 0; bar.st = nullptr;
    if (a.use_bar) bar = xcd_barrier_post((unsigned*)(ws + WS_CTL) + 4096, MISC + 8);
#define P_IN(i) (a.in[i])
#define WSP(T, off) ((T*)(wsq + (off)))

    for (int ph = a.ph_lo; ph < a.ph_hi; ++ph) {
        unsigned char* wsq = a.ws; asm volatile("" : "+s"(wsq));
        if (ph == 0) {
            const int tid_ = tid_opaque(), lane = tid_ & 63, wave = __builtin_amdgcn_readfirstlane(tid_ >> 6), gw = bid_opaque() * 8 + wave, NGW = G * 8;
            LAS float* scr = (LAS float*)(lds + wave * 16384);
            constexpr int I_IN = 16 * (NP / 32), I_OUT = 16 * 32, I_MKV = 16 * 16, I_W1 = 32 * 8, I_W2 = 4 * 2;
            constexpr int PER_L = I_IN + I_OUT + I_MKV + 2 * I_W1 + 2 * I_W2;
            for (int it = gw; it < L_ * PER_L; it += NGW) {
                const int l = it / PER_L; int r = it % PER_L;
                if (r < I_IN) { misc::transpose_item<1>(P_IN(5) + (size_t)l * D_ * INW, INW, D_, NP, WSP(bf16_t, WS_WIN) + (size_t)l * NP * D_, scr, r, lane); continue; } r -= I_IN;
                if (r < I_OUT) { misc::transpose_item<0>(P_IN(16) + (size_t)l * D_ * D_, D_, D_, D_, WSP(bf16_t, WS_WOUT) + (size_t)l * D_ * D_, scr, r, lane); continue; } r -= I_OUT;
                if (r < I_MKV) { misc::transpose_item<0>(P_IN(15) + (size_t)l * D_ * 512, 512, D_, 512, WSP(bf16_t, WS_WMKV) + (size_t)l * 512 * D_, scr, r, lane); continue; } r -= I_MKV;
                if (r < 2 * I_W1) { const int kv = r / I_W1; misc::transpose_item<2>((kv ? P_IN(13) : P_IN(10)) + (size_t)l * 2048 * 256, 256, 2048, 256, WSP(bf16_t, WS_W1T) + (size_t)(l * 2 + kv) * 524288, scr, r % I_W1, lane); continue; } r -= 2 * I_W1;
                { const int kv = r / I_W2; misc::transpose_item<0>((kv ? P_IN(14) : P_IN(11)) + (size_t)l * 256 * 64, 64, 256, 64, WSP(bf16_t, WS_W2T) + (size_t)(l * 2 + kv) * 16384, scr, r % I_W2, lane); }
            }
            for (int it = gw; it < L_ * 2 * 4; it += NGW) {
                const int l = it >> 3, kv = (it >> 2) & 1, j = (it & 3) * 64 + lane;
                const float* pos = (kv ? P_IN(12) : P_IN(9)) + (size_t)l * 2048; const float* w1 = (kv ? P_IN(13) : P_IN(10)) + (size_t)l * 2048 * 256;
                float acc = 0.f;
                for (int k = 0; k < 2048; ++k) acc += pos[k] * w1[(size_t)k * 256 + j];
                WSP(float, WS_CB1)[(l * 2 + kv) * 256 + j] = acc;
            }
            for (int it = gw; it < L_ * B_ * NMEM; it += NGW) { const int l = it / (B_ * NMEM), r = it % (B_ * NMEM);
                misc::rms_row(P_IN(1) + (size_t)r * D_, P_IN(4) + (size_t)l * D_, WSP(bf16_t, WS_MEMN) + ((size_t)l * B_ * NMEM + r) * D_, lane); }
            for (int m = gw; m < M_; m += NGW) misc::rms_row(P_IN(0) + (size_t)m * D_, P_IN(2), WSP(bf16_t, WS_XN) + (size_t)m * D_, lane);
        } else {
            const int l = (ph - 1) / 5, sub = (ph - 1) % 5;
#ifdef REP_SUB
            const int nrep = (sub == REP_SUB) ? 2 : 1;
#else
            const int nrep = 1;
#endif
            for (int rep = 0; rep < nrep; ++rep) {
            if (sub == 0) {
#ifndef DIS_GEMM
#ifndef DIS_INP
                { pg8::Gemm g{WSP(bf16_t, WS_XN), WSP(bf16_t, WS_WIN) + (size_t)l * NP * D_, M_, NP, D_}; pg8::StaticOrder S; S.init(M_, NP, G, bid_opaque());
                  pg8::EpiProjF E{WSP(bf16_t, WS_PROJ), WSP(bf16_t, WS_CMPB)};
                  pg8::gemm_phase<pg8::EpiProjF, pg8::StaticOrder, true, true>(lds, g, S, E); }
#endif
#ifndef DIS_MKV
                if (l == 0) {
                    for (int ll = 0; ll < L_; ++ll) {
                        pg8::Gemm g{WSP(bf16_t, WS_MEMN) + (size_t)ll * B_ * NMEM * D_, WSP(bf16_t, WS_WMKV) + (size_t)ll * 512 * D_, B_ * NMEM, 512, D_}; pg8::StaticOrder S; S.init(B_ * NMEM, 512, G, (int)((bid_opaque() + G - 8 * ll) % G));
                        pg8::EpiMkvF E{WSP(bf16_t, WS_MKV) + (size_t)ll * B_ * NMEM * 512};
                        pg8::gemm_phase<pg8::EpiMkvF, pg8::StaticOrder, true, true>(lds, g, S, E);
                    }
                }
#endif
#endif
            } else if (sub == 1) {
#ifndef DIS_CMP
                cmpf::compress_phase(lds, WSP(bf16_t, WS_CMPB), WSP(bf16_t, WS_W1T) + (size_t)l * 2 * 524288, WSP(float, WS_CB1) + l * 512, WSP(bf16_t, WS_W2T) + (size_t)l * 2 * 16384, WSP(bf16_t, WS_KVC));
#endif
            } else if (sub == 2) {
#ifndef DIS_ATT
                att::att_phase(lds, WSP(bf16_t, WS_PROJ), WSP(bf16_t, WS_KVC), WSP(bf16_t, WS_MKV) + (size_t)l * B_ * NMEM * 512, P_IN(6) + l * 24, P_IN(7) + (size_t)l * 768, P_IN(8) + (size_t)l * 256, WSP(bf16_t, WS_Y));
#endif
            } else if (sub == 3) {
#if !defined(DIS_GEMM) && !defined(DIS_OUTP)
                pg8::Gemm g{WSP(bf16_t, WS_Y), WSP(bf16_t, WS_WOUT) + (size_t)l * D_ * D_, M_, D_, D_}; pg8::StaticOrder S; S.init(M_, D_, G, bid_opaque());
                pg8::EpiZF E{WSP(float, WS_PROJ)};
                pg8::gemm_phase<pg8::EpiZF, pg8::StaticOrder, true, true>(lds, g, S, E);
#endif
            } else {
                const int tid_ = tid_opaque(), lane = tid_ & 63, wave = __builtin_amdgcn_readfirstlane(tid_ >> 6), gw = bid_opaque() * 8 + wave, NGW = G * 8;
                const float* xin = l == 0 ? P_IN(0) : a.out;
                for (int m = gw; m < M_; m += NGW)
                    misc::resid_row(WSP(float, WS_PROJ) + (size_t)m * D_, xin + (size_t)m * D_, P_IN(3) + (size_t)l * D_, l + 1 < L_ ? P_IN(2) + (size_t)(l + 1) * D_ : nullptr, a.out + (size_t)m * D_, WSP(bf16_t, WS_XN) + (size_t)m * D_, lane);
            }
            }
        }
        if (ph + 1 < a.ph_hi) { if (a.use_bar) { if (ph == 0) cooperative_groups::this_grid().sync(); else xcd_barrier(bar); } else __syncthreads(); }
        else { asm volatile("s_waitcnt vmcnt(0)" ::: "memory"); __syncthreads(); }
    }
}

#ifndef FAST_GEMM
#define FAST_GEMM 1
#endif
#ifndef FAST_CMP
#define FAST_CMP 1
#endif
#ifndef FAST_ATT
#define FAST_ATT 1
#endif
#ifndef ONE_LAUNCH
#define ONE_LAUNCH 1
#endif
static void launch_mega(const Args& base, int lo, int hi, int use_bar, int grid, hipStream_t stream) {
    Args a = base; a.ph_lo = lo; a.ph_hi = hi; a.use_bar = use_bar; a.pad = 0;
    if (use_bar) {
        void* params[] = {(void*)&a};
        hipError_t e = hipLaunchCooperativeKernel((const void*)mega, dim3(grid), dim3(512), params, LDS_BYTES, stream);
        if (e != hipSuccess) fprintf(stderr, "cooperative launch failed: %s (grid %d)\n", hipGetErrorString(e), grid);
    } else {
        hipLaunchKernelGGL(mega, dim3(grid), dim3(512), LDS_BYTES, stream, a);
    }
}
extern "C" void kernel_launch(void* const* d_in, const int* in_sizes, int n_in, void* d_out, int out_size, void* d_ws, size_t ws_size, hipStream_t stream) {
    static int grid = 0;
    if (grid == 0) {
        if (n_in != 17 || ws_size < WS_TOTAL || out_size != M_ * D_) { fprintf(stderr, "kernel_launch: bad args n_in %d ws %zu need %zu out %d\n", n_in, ws_size, (size_t)WS_TOTAL, out_size); grid = -1; return; }
        int dev = 0, cus = 0, per_cu = 0;
        if (hipGetDevice(&dev) != hipSuccess || hipDeviceGetAttribute(&cus, hipDeviceAttributeMultiprocessorCount, dev) != hipSuccess) { grid = -1; return; }
        if (hipFuncSetAttribute((const void*)mega, hipFuncAttributeMaxDynamicSharedMemorySize, LDS_BYTES) != hipSuccess) { fprintf(stderr, "hipFuncSetAttribute failed\n"); grid = -1; return; }
        if (hipOccupancyMaxActiveBlocksPerMultiprocessor(&per_cu, (const void*)mega, 512, LDS_BYTES) != hipSuccess || per_cu < 1) { fprintf(stderr, "occupancy query: %d\n", per_cu); per_cu = 1; }
        (void)hipGetLastError();
        grid = cus;
    }
    if (grid < 0) return;
    Args a{};
    for (int i = 0; i < 17; ++i) a.in[i] = (const float*)d_in[i];
    a.out = (float*)d_out; a.ws = (unsigned char*)d_ws;
    unsigned char* ws = (unsigned char*)d_ws; float* out = (float*)d_out;
    (void)hipMemsetAsync(ws + WS_CTL, 0, CTL_BYTES, stream);
#if ONE_LAUNCH
    launch_mega(a, 0, NPHASE, 1, grid, stream);
#else
    const float* x = (const float*)d_in[0];
    const float* pre_g = (const float*)d_in[2]; const float* post_g = (const float*)d_in[3];
    const float* b_gate = (const float*)d_in[6]; const float* conv_w = (const float*)d_in[7]; const float* conv_b = (const float*)d_in[8];
    const float* pos_k = (const float*)d_in[9]; const float* w1_k = (const float*)d_in[10]; const float* w2_k = (const float*)d_in[11];
    const float* pos_v = (const float*)d_in[12]; const float* w1_v = (const float*)d_in[13]; const float* w2_v = (const float*)d_in[14];
    bf16_t* Wt_in = (bf16_t*)(ws + WS_WIN); bf16_t* Wt_out = (bf16_t*)(ws + WS_WOUT);
    bf16_t* mkv = (bf16_t*)(ws + WS_MKV); bf16_t* XN = (bf16_t*)(ws + WS_XN);
    bf16_t* cmpb = (bf16_t*)(ws + WS_CMPB); bf16_t* kvc = (bf16_t*)(ws + WS_KVC); bf16_t* Y = (bf16_t*)(ws + WS_Y);
    bf16_t* proj = (bf16_t*)(ws + WS_PROJ); float* Z = (float*)(ws + WS_PROJ);
    launch_mega(a, 0, 1, 0, grid, stream);
    for (int l = 0; l < L_; ++l) {
        const int p0 = 1 + 5 * l;
#if FAST_GEMM
        launch_mega(a, p0, p0 + 1, 0, grid, stream);
#else
        k_gemm_naive<EpiProj><<<dim3(NP / 64, M_ / 64), 256, 0, stream>>>(XN, Wt_in + (size_t)l * NP * D_, D_, EpiProj{proj, cmpb});
        if (l == 0) for (int ll = 0; ll < L_; ++ll)
            k_gemm_naive<EpiMkv><<<dim3(512 / 64, B_ * NMEM / 64), 256, 0, stream>>>((bf16_t*)(ws + WS_MEMN) + (size_t)ll * B_ * NMEM * D_, (bf16_t*)(ws + WS_WMKV) + (size_t)ll * 512 * D_, D_, EpiMkv{mkv + (size_t)ll * B_ * NMEM * 512});
#endif
#if FAST_CMP
        launch_mega(a, p0 + 1, p0 + 2, 0, grid, stream);
#else
        k_compress_naive<<<2 * 8 * 512, 256, 0, stream>>>(cmpb, pos_k + (size_t)l * 2048, w1_k + (size_t)l * 2048 * 256, w2_k + (size_t)l * 256 * 64,
                                                          pos_v + (size_t)l * 2048, w1_v + (size_t)l * 2048 * 256, w2_v + (size_t)l * 256 * 64, kvc);
#endif
#if FAST_ATT
        launch_mega(a, p0 + 2, p0 + 3, 0, grid, stream);
#else
        k_nsa_naive<<<M_ * 2, 64, 0, stream>>>(proj, kvc, b_gate + l * 24, Y);
        k_mem_naive<<<M_ * 4, 64, 0, stream>>>(proj, mkv + (size_t)l * B_ * NMEM * 512, Y);
        k_conv<<<M_, 256, 0, stream>>>(proj, conv_w + (size_t)l * 3 * 256, conv_b + (size_t)l * 256, Y);
#endif
#if FAST_GEMM
        launch_mega(a, p0 + 3, p0 + 4, 0, grid, stream);
#else
        k_gemm_naive<EpiZ><<<dim3(D_ / 64, M_ / 64), 256, 0, stream>>>(Y, Wt_out + (size_t)l * D_ * D_, D_, EpiZ{Z});
#endif
        launch_mega(a, p0 + 4, p0 + 5, 0, grid, stream);
    }
#endif
}
```
